# Optimizing an MI355X kernel written in HIP

```python
import jax, jax.numpy as jnp
from jax import lax
import numpy as np

D_MODEL = 2048
BATCH = 2
SEQ = 8192
DEPTH = 1

PLE_DIM = 256

ATTN_HEADS = 16
ATTN_KV_HEADS = 4
ATTN_HEAD_DIM = 64
ATTN_GROUP = ATTN_HEADS // ATTN_KV_HEADS
ATTN_Q_WIDTH = ATTN_HEADS * ATTN_HEAD_DIM
ATTN_KV_WIDTH = ATTN_KV_HEADS * ATTN_HEAD_DIM
WINDOW = 128
ATTN_BLOCK = 128
ROPE_THETA = 10000.0

HGRN_WIDTH = D_MODEL // 2
HGRN_EXPAND = 128
HGRN_HEADS = HGRN_WIDTH // HGRN_EXPAND
HGRN_DK = HGRN_EXPAND
HGRN_DV = HGRN_WIDTH // HGRN_HEADS
HGRN_CHUNK = 64

D_FF = ((8 * D_MODEL + 3 * 256 - 1) // (3 * 256)) * 256

RMS_EPS = 1e-6

IN_SIZES = (ATTN_Q_WIDTH, ATTN_KV_WIDTH, ATTN_KV_WIDTH,
            HGRN_HEADS * HGRN_DK, HGRN_HEADS * HGRN_DK, HGRN_HEADS * HGRN_DV, HGRN_HEADS * HGRN_DV,
            D_MODEL, D_MODEL)
IN_WIDTH = sum(IN_SIZES)

kernel_name = "hybrid_swa_sink_hgrn2_gated_block"


def rms_norm(x, gain):
    xf = x.astype(jnp.float32)
    y = xf * lax.rsqrt(jnp.mean(xf * xf, axis=-1, keepdims=True) + RMS_EPS)
    return (y * gain.astype(jnp.float32)).astype(x.dtype)


def rotary(t, positions):
    half = t.shape[-1] // 2
    inv_freq = ROPE_THETA ** (-jnp.arange(half, dtype=jnp.float32) / half)
    ang = positions.astype(jnp.float32)[..., None] * inv_freq
    cos = jnp.cos(ang)[:, :, None, :]
    sin = jnp.sin(ang)[:, :, None, :]
    t1 = t[..., :half].astype(jnp.float32)
    t2 = t[..., half:].astype(jnp.float32)
    return jnp.concatenate([t1 * cos - t2 * sin, t2 * cos + t1 * sin], axis=-1).astype(t.dtype)


def sliding_window_attention(q, k, v, sinks):
    B, S, _, D = q.shape
    nb = S // ATTN_BLOCK
    qb = q.reshape(B, nb, ATTN_BLOCK, ATTN_KV_HEADS, ATTN_GROUP, D)

    def band(t):
        tp = jnp.pad(t, ((0, 0), (ATTN_BLOCK, 0), (0, 0), (0, 0)))
        tb = tp.reshape(B, nb + 1, ATTN_BLOCK, ATTN_KV_HEADS, D)
        return jnp.concatenate([tb[:, :-1], tb[:, 1:]], axis=2)

    kb, vb = band(k), band(v)
    scores = jnp.einsum('bnqhgd,bnkhd->bnhgqk', qb, kb,
                        preferred_element_type=jnp.float32) * (D ** -0.5)
    qi = jnp.arange(ATTN_BLOCK)[:, None] + ATTN_BLOCK
    ki = jnp.arange(2 * ATTN_BLOCK)[None, :]
    local = (ki <= qi) & (qi - ki < WINDOW)
    not_pad = (jnp.arange(nb) > 0)[:, None, None] | (ki >= ATTN_BLOCK)[None]
    valid = local[None] & not_pad
    scores = jnp.where(valid[None, :, None, None], scores, -jnp.inf)
    sink = jnp.broadcast_to(
        sinks.astype(jnp.float32).reshape(1, 1, ATTN_KV_HEADS, ATTN_GROUP, 1, 1),
        scores.shape[:-1] + (1,))
    probs = jax.nn.softmax(jnp.concatenate([scores, sink], axis=-1), axis=-1)[..., :-1]
    out = jnp.einsum('bnhgqk,bnkhd->bnqhgd', probs.astype(v.dtype), vb)
    return out.reshape(B, S, ATTN_HEADS * D)


def hgrn2_recurrence(q, f_logit, i, lb):
    B, S = q.shape[0], q.shape[1]
    nc = S // HGRN_CHUNK
    lb = lb.astype(jnp.float32)
    z = f_logit.astype(jnp.float32)
    log_f = jnp.log(lb + (1.0 - lb) * jax.nn.sigmoid(z))
    k = (1.0 - lb) * jax.nn.sigmoid(-z)
    qf = jax.nn.silu(q.astype(jnp.float32)) * (HGRN_DK ** -0.5)
    vf = i.astype(jnp.float32)

    def to_chunks(t):
        return t.reshape(B, nc, HGRN_CHUNK, HGRN_HEADS, t.shape[-1]).transpose(1, 0, 3, 2, 4)

    qc, kc, vc = to_chunks(qf), to_chunks(k), to_chunks(vf)
    bc = jnp.cumsum(to_chunks(log_f), axis=3)
    causal = jnp.tril(jnp.ones((HGRN_CHUNK, HGRN_CHUNK), dtype=bool))

    def step(state, inp):
        q_c, k_c, v_c, b_c = inp
        b_last = b_c[:, :, -1:, :]
        o_inter = jnp.einsum('bhtk,bhkv->bhtv', q_c * jnp.exp(b_c), state)
        diff = b_c[:, :, :, None, :] - b_c[:, :, None, :, :]
        decay = jnp.exp(jnp.where(causal[:, :, None], diff, -jnp.inf))
        scores = jnp.einsum('bhtk,bhsk,bhtsk->bhts', q_c, k_c, decay)
        o_intra = jnp.einsum('bhts,bhsv->bhtv', scores, v_c)
        new_state = (jnp.exp(b_last[:, :, 0, :])[..., None] * state
                     + jnp.einsum('bhsk,bhsv->bhkv', k_c * jnp.exp(b_last - b_c), v_c))
        return new_state, o_inter + o_intra

    state0 = jnp.zeros((B, HGRN_HEADS, HGRN_DK, HGRN_DV), jnp.float32)
    _, o = lax.scan(step, state0, (qc, kc, vc, bc))
    return o.transpose(1, 0, 3, 2, 4).reshape(B, S, HGRN_HEADS, HGRN_DV).astype(q.dtype)


def setup_inputs(seed: int = 0) -> dict:
    key = jax.random.key(seed)
    ks = jax.random.split(key, 20)

    def dense(k, fan_in, fan_out):
        return jax.random.normal(k, (DEPTH, fan_in, fan_out), jnp.float32) * fan_in ** -0.5

    def gain(k, n):
        return 1.0 + 0.02 * jax.random.normal(k, (DEPTH, n), jnp.float32)

    return {
        "x": jax.random.normal(ks[0], (BATCH, SEQ, D_MODEL), jnp.float32),
        "p": jax.random.normal(ks[1], (DEPTH, BATCH, SEQ, PLE_DIM), jnp.float32),
        "positions": jnp.broadcast_to(jnp.arange(SEQ, dtype=jnp.int32), (BATCH, SEQ)),
        "g_mix_pre": gain(ks[2], D_MODEL),
        "w_in": dense(ks[3], D_MODEL, IN_WIDTH),
        "attn_sinks": jax.random.normal(ks[4], (DEPTH, ATTN_HEADS), jnp.float32),
        "hgrn_lb_logits": 0.5 * jax.random.normal(ks[5], (DEPTH + 1, HGRN_HEADS * HGRN_DK), jnp.float32),
        "hgrn_gnorm": gain(ks[6], HGRN_DV),
        "w_attn_branch": dense(ks[7], ATTN_Q_WIDTH, D_MODEL),
        "w_hgrn_branch": dense(ks[8], HGRN_HEADS * HGRN_DV, D_MODEL),
        "w_out": dense(ks[9], D_MODEL, D_MODEL),
        "g_mix_post": gain(ks[10], D_MODEL),
        "g_ffn_pre": gain(ks[11], D_MODEL),
        "w_gate_up": dense(ks[12], D_MODEL, 2 * D_FF),
        "w_down": dense(ks[13], D_FF, D_MODEL),
        "g_ffn_post": gain(ks[14], D_MODEL),
        "g_ple_pre": gain(ks[15], D_MODEL),
        "w_ple_gate": dense(ks[16], D_MODEL, D_MODEL),
        "w_ple_proj": dense(ks[17], PLE_DIM, D_MODEL),
        "g_ple_post": gain(ks[18], D_MODEL),
    }


def reference(x, p, positions, g_mix_pre, w_in, attn_sinks, hgrn_lb_logits, hgrn_gnorm,
              w_attn_branch, w_hgrn_branch, w_out, g_mix_post, g_ffn_pre, w_gate_up, w_down,
              g_ffn_post, g_ple_pre, w_ple_gate, w_ple_proj, g_ple_post):
    B, S, _ = x.shape
    split_at = np.cumsum(IN_SIZES)[:-1].tolist()
    lb_all = jnp.cumsum(jax.nn.softmax(hgrn_lb_logits.astype(jnp.float32), axis=0), axis=0)
    for layer in range(DEPTH):
        h = rms_norm(x, g_mix_pre[layer])
        proj = h @ w_in[layer]
        aq, ak, av, hq, hf, hi, hg, gate_a, gate_b = jnp.split(proj, split_at, axis=-1)

        aq = rotary(aq.reshape(B, S, ATTN_HEADS, ATTN_HEAD_DIM), positions)
        ak = rotary(ak.reshape(B, S, ATTN_KV_HEADS, ATTN_HEAD_DIM), positions)
        av = av.reshape(B, S, ATTN_KV_HEADS, ATTN_HEAD_DIM)
        y_attn = sliding_window_attention(aq, ak, av, attn_sinks[layer])

        o = hgrn2_recurrence(hq.reshape(B, S, HGRN_HEADS, HGRN_DK),
                             hf.reshape(B, S, HGRN_HEADS, HGRN_DK),
                             hi.reshape(B, S, HGRN_HEADS, HGRN_DV),
                             lb_all[layer].reshape(HGRN_HEADS, HGRN_DK))
        o = rms_norm(o, hgrn_gnorm[layer]) * jax.nn.silu(hg.reshape(B, S, HGRN_HEADS, HGRN_DV))
        y_hgrn = o.reshape(B, S, HGRN_HEADS * HGRN_DV)

        merged = (jax.nn.sigmoid(gate_a) * (y_attn @ w_attn_branch[layer])
                  + jax.nn.sigmoid(gate_b) * (y_hgrn @ w_hgrn_branch[layer]))
        x = x + rms_norm(merged @ w_out[layer], g_mix_post[layer])

        h = rms_norm(x, g_ffn_pre[layer])
        gate, up = jnp.split(h @ w_gate_up[layer], 2, axis=-1)
        x = x + rms_norm((jax.nn.silu(gate) * up) @ w_down[layer], g_ffn_post[layer])

        ple_gate = jax.nn.sigmoid(rms_norm(x, g_ple_pre[layer]) @ w_ple_gate[layer])
        e = (p[layer].astype(x.dtype) @ w_ple_proj[layer]) * ple_gate
        x = x + rms_norm(e, g_ple_post[layer])
    return x
```

```cpp
#include <hip/hip_runtime.h>
#include <hip/hip_cooperative_groups.h>
#include <cstdio>
#include <cstdint>
namespace cg = cooperative_groups;

#define LAS __attribute__((address_space(3)))
typedef unsigned short bf16_t;
typedef short bf16x8 __attribute__((ext_vector_type(8)));
typedef short bf16x4 __attribute__((ext_vector_type(4)));
typedef float f32x4 __attribute__((ext_vector_type(4)));
typedef float f32x2 __attribute__((ext_vector_type(2)));
typedef unsigned u32x4 __attribute__((ext_vector_type(4)));
typedef unsigned u32x2 __attribute__((ext_vector_type(2)));

constexpr int T = 16384, SEQ = 8192, DM = 2048, INW = 9728, DFF = 5632, NGU = 11264;
constexpr float RMS_EPS = 1e-6f;
constexpr size_t MiB = 1u << 20;
constexpr size_t WS_LB = 65536;
constexpr size_t WS_WMRG = 1 * MiB, WS_WOUT = 9 * MiB, WS_WGU = 17 * MiB, WS_WDN = 61 * MiB, WS_WPG = 83 * MiB, WS_WPP = 91 * MiB;
constexpr size_t WS_HB = 92 * MiB;
constexpr size_t WS_PB = 156 * MiB;
constexpr size_t WS_ROPE = 164 * MiB;
constexpr size_t WS_DC = 164 * MiB;
constexpr size_t WS_PART = 166 * MiB;
constexpr size_t WS_BIG = 168 * MiB;
constexpr size_t WS_WIN = WS_BIG, WS_Q = 206 * MiB, WS_K = 238 * MiB, WS_VT = 246 * MiB, WS_HQ = 254 * MiB, WS_HZ = 286 * MiB, WS_HVT = 318 * MiB,
                 WS_HG = 350 * MiB, WS_GSA = 382 * MiB, WS_GSB = 446 * MiB, WS_END = 510 * MiB;
constexpr size_t WS_ST = WS_BIG;
constexpr size_t WS_MRG = WS_HQ;
constexpr size_t WS_ACT = 334 * MiB;
constexpr size_t WS_Y1 = WS_BIG;
constexpr size_t WS_Y2 = WS_BIG;
constexpr size_t WS_E0 = 334 * MiB;
constexpr size_t WS_E = WS_BIG;
constexpr size_t WS_X2 = 398 * MiB;
constexpr int LDS_BYTES = 159744;
constexpr int LDS_CTL = LDS_BYTES - 1024;

typedef float f32x2_t_ __attribute__((ext_vector_type(2)));
typedef __bf16 bf16x2_t_ __attribute__((ext_vector_type(2)));
__device__ __forceinline__ unsigned cvtpk_(float lo, float hi) { const f32x2_t_ v = {lo, hi}; const bf16x2_t_ b = __builtin_convertvector(v, bf16x2_t_); return __builtin_bit_cast(unsigned, b); }
__device__ __forceinline__ unsigned f2bf(float f) { return cvtpk_(f, f) & 0xffffu; }
__device__ __forceinline__ float bf2f(unsigned h) { return __builtin_bit_cast(float, h << 16); }
__device__ __forceinline__ unsigned pk2(float lo, float hi) { return cvtpk_(lo, hi); }
__device__ __forceinline__ unsigned f2bf_sw(float f) { unsigned u = __builtin_bit_cast(unsigned, f); return (u + 0x7fffu + ((u >> 16) & 1u)) >> 16; }
__device__ __forceinline__ unsigned pk2_sw(float lo, float hi) { return f2bf_sw(lo) | (f2bf_sw(hi) << 16); }
__device__ __forceinline__ float bflo(unsigned w) { return __builtin_bit_cast(float, w << 16); }
__device__ __forceinline__ float bfhi(unsigned w) { return __builtin_bit_cast(float, w & 0xffff0000u); }
__device__ __forceinline__ float wave_sum(float v) {
#pragma unroll
    for (int o = 1; o < 64; o <<= 1) v += __shfl_xor(v, o);
    return v;
}
__device__ __forceinline__ float sigmoidf_(float x) { return __builtin_amdgcn_rcpf(1.0f + __expf(-x)); }
__device__ __forceinline__ f32x4 mfma16(bf16x8 a, bf16x8 b, f32x4 c) { return __builtin_amdgcn_mfma_f32_16x16x32_bf16(a, b, c, 0, 0, 0); }

namespace pg8 {
constexpr int BM = 256, BK = 64, HALF = 128, HTB = HALF * BK * 2, NXCD = 8, WGM = 8;
__host__ __device__ __forceinline__ int lds_byte(int r, int c) { const int st = (r >> 4) * 2 + (c >> 5), rr = r & 15, cc = c & 31, ob = rr * 64 + cc * 2; return st * 1024 + (ob ^ (((ob >> 9) & 1) << 5)); }
__host__ __device__ __forceinline__ void stage_rc(int b, int& R, int& C) { const int st = b / 1024, sb = b % 1024, swz = sb ^ (((sb >> 9) & 1) << 5); R = (st >> 1) * 16 + swz / 64; C = (st & 1) * 32 + (swz % 64) / 2; }
__host__ __device__ __forceinline__ int perm32(int rho) { const int n = rho >> 4, i = rho & 15; return 8 * (i >> 2) + 4 * n + (i & 3); }

struct Unit { int pm, pn, koff, half; };
struct Gemm { const bf16_t* A; const bf16_t* Bt; int ld; int nt; };

struct StaticOrder {
    int nM, nN, nwg, G, c;
    __device__ void init(int M, int N, int G_, int c_) { nM = M / BM; nN = N / BM; nwg = nM * nN; G = G_; c = c_; }
    __device__ bool next(int i, Unit& u) const {
        const long L = (long)i * G + c; if (L >= nwg) return false;
        int wgid = (int)L; { const int q = nwg / NXCD, r = nwg % NXCD, xcd = wgid % NXCD, off = wgid / NXCD; wgid = (xcd < r ? xcd * (q + 1) : r * (q + 1) + (xcd - r) * q) + off; }
        const int nig = WGM * nN, gid = wgid / nig, fm = gid * WGM, gsz = (nM - fm) < WGM ? (nM - fm) : WGM;
        u.pm = fm + ((wgid % nig) % gsz); u.pn = (wgid % nig) / gsz; u.koff = 0; u.half = 0; return true;
    }
};
struct SplitKOrder {
    StaticOrder b; int kbytes;
    __device__ bool next(int i, Unit& u) const { if (!b.next(i >> 1, u)) return false; u.half = i & 1; u.koff = (i & 1) * kbytes; return true; }
};

__device__ __forceinline__ unsigned cvt_pk_bf16(float lo, float hi) { unsigned r; asm volatile("v_cvt_pk_bf16_f32 %0, %1, %2" : "=v"(r) : "v"(lo), "v"(hi)); return r; }
__device__ __forceinline__ u32x4 pack8(f32x4 a, f32x4 b) { u32x4 w; w.x = cvt_pk_bf16(a[0], a[1]); w.y = cvt_pk_bf16(a[2], a[3]); w.z = cvt_pk_bf16(b[0], b[1]); w.w = cvt_pk_bf16(b[2], b[3]); return w; }

template <class Epi, class Sched>
__device__ __forceinline__ void gemm_phase(LAS unsigned char* lds, const Gemm g, const Sched& S, const Epi& E, int tid_in) {
    int tid_ = tid_in; asm volatile("" : "+v"(tid_));
    const int tid = tid_, wid = __builtin_amdgcn_readfirstlane(tid >> 6), lane = tid & 63, wr = wid >> 2, wc = wid & 3, fr = lane & 15, fq = lane >> 4;
    const int K = g.ld, nt = g.nt;
    unsigned voffA[2], voffB[2];
#pragma unroll
    for (int i = 0; i < 2; ++i) { int R, C; stage_rc(tid * 16 + i * 8192, R, C); const int Rb = (R & ~31) + perm32(R & 31);
        voffA[i] = (unsigned)(R * K + C) * 2u; voffB[i] = (unsigned)(Rb * K + C) * 2u; }
    const size_t kstep = (size_t)(BK * 2);
    const size_t hstep = (size_t)HALF * K * 2;
    const size_t tstep = 2 * hstep;
    const unsigned ldsw = (unsigned)wid * 1024u;
    const int aoff = lds_byte(wr * 64 + fr, fq * 8), boff = lds_byte(wc * 32 + fr, fq * 8);
#define PG8_SA(b, h) (((b) * 2 + (h)) * HTB)
#define PG8_SB(b, h) ((4 + (b) * 2 + (h)) * HTB)
#define PG8_STAGE(bufoff, gbase, voff) do { _Pragma("unroll") for (int _i = 0; _i < 2; ++_i) \
        __builtin_amdgcn_global_load_lds((const unsigned*)((const char*)(gbase) + (voff)[_i]), (LAS unsigned*)(lds + (bufoff) + ldsw + _i * 8192), 16, 0, 0); } while (0)
#define PG8_LDA(dst, b, h) do { _Pragma("unroll") for (int m = 0; m < 4; ++m) _Pragma("unroll") for (int k = 0; k < 2; ++k) dst[m][k] = *(const LAS bf16x8*)(lds + PG8_SA(b, h) + aoff + m * 2048 + k * 1024); } while (0)
#define PG8_LDB(dst, b, h) do { _Pragma("unroll") for (int n = 0; n < 2; ++n) _Pragma("unroll") for (int k = 0; k < 2; ++k) dst[n][k] = *(const LAS bf16x8*)(lds + PG8_SB(b, h) + boff + n * 2048 + k * 1024); } while (0)
#define PG8_MMA(ai, bj, At, Bt) do { __builtin_amdgcn_s_setprio(1); _Pragma("unroll") for (int m = 0; m < 4; ++m) _Pragma("unroll") for (int n = 0; n < 2; ++n) _Pragma("unroll") for (int k = 0; k < 2; ++k) \
        acc[ai][bj][m][n] = __builtin_amdgcn_mfma_f32_16x16x32_bf16(Bt[n][k], At[m][k], acc[ai][bj][m][n], 0, 0, 0); __builtin_amdgcn_s_setprio(0); } while (0)
#define PG8_WAIT_V(n) asm volatile("s_waitcnt vmcnt(" #n ")" ::: "memory")
#define PG8_WAIT_L(n) asm volatile("s_waitcnt lgkmcnt(" #n ")" ::: "memory")
#define PG8_BAR __builtin_amdgcn_s_barrier()
#define PG8_SCHED __builtin_amdgcn_sched_barrier(0)
    Unit cur, nxt; int ui = 0;
    if (!S.next(0, cur)) return;
    f32x4 acc[2][2][4][2];
#pragma unroll
    for (int a = 0; a < 2; ++a)
#pragma unroll
        for (int b = 0; b < 2; ++b)
#pragma unroll
            for (int m = 0; m < 4; ++m)
#pragma unroll
                for (int n = 0; n < 2; ++n) acc[a][b][m][n] = (f32x4){0.f, 0.f, 0.f, 0.f};
    bf16x8 At[4][2], B0[2][2], B1[2][2];
    const char* cA = (const char*)g.A + (size_t)cur.pm * tstep + cur.koff; const char* cB = (const char*)g.Bt + (size_t)cur.pn * tstep + cur.koff;
    PG8_STAGE(PG8_SB(0, 0), cB, voffB); PG8_STAGE(PG8_SB(0, 1), cB + hstep, voffB); PG8_STAGE(PG8_SA(0, 0), cA, voffA); PG8_STAGE(PG8_SA(0, 1), cA + hstep, voffA);
    if (wr == 1) PG8_BAR;
    PG8_WAIT_V(2); PG8_BAR;
    PG8_STAGE(PG8_SB(1, 0), cB + kstep, voffB); PG8_STAGE(PG8_SB(1, 1), cB + hstep + kstep, voffB);
    PG8_WAIT_V(4); PG8_BAR;
    for (;;) {
        const bool has_next = S.next(ui + 1, nxt);
        const char* nA = has_next ? (const char*)g.A + (size_t)nxt.pm * tstep + nxt.koff : cA; const char* nB = has_next ? (const char*)g.Bt + (size_t)nxt.pn * tstep + nxt.koff : cB;
        for (int t = 0; t < nt; t += 2) {
            const bool last = (t == nt - 2);
            const char* a1 = cA + (size_t)(t + 1) * kstep;
            const char* a2 = last ? nA : cA + (size_t)(t + 2) * kstep; const char* b2 = last ? nB : cB + (size_t)(t + 2) * kstep;
            const char* a3 = a2 + kstep; const char* b3 = b2 + kstep;
            PG8_LDB(B0, 0, 0); PG8_LDB(B1, 0, 1); PG8_SCHED; PG8_LDA(At, 0, 0); PG8_STAGE(PG8_SA(1, 0), a1, voffA); PG8_STAGE(PG8_SA(1, 1), a1 + hstep, voffA);
            PG8_WAIT_V(8); PG8_WAIT_L(0); PG8_BAR; PG8_MMA(0, 0, At, B0); PG8_MMA(0, 1, At, B1); PG8_BAR; PG8_SCHED;
            PG8_LDA(At, 0, 1); PG8_STAGE(PG8_SB(0, 0), b2, voffB); PG8_STAGE(PG8_SB(0, 1), b2 + hstep, voffB);
            PG8_WAIT_V(6); PG8_WAIT_L(0); PG8_BAR; PG8_MMA(1, 0, At, B0); PG8_MMA(1, 1, At, B1); PG8_BAR; PG8_SCHED;
            PG8_LDB(B0, 1, 0); PG8_LDB(B1, 1, 1); PG8_SCHED; PG8_LDA(At, 1, 0); PG8_STAGE(PG8_SA(0, 0), a2, voffA); PG8_STAGE(PG8_SA(0, 1), a2 + hstep, voffA);
            PG8_WAIT_V(8); PG8_WAIT_L(0); PG8_BAR; PG8_MMA(0, 0, At, B0); PG8_MMA(0, 1, At, B1); PG8_BAR; PG8_SCHED;
            PG8_LDA(At, 1, 1); PG8_STAGE(PG8_SB(1, 0), b3, voffB); PG8_STAGE(PG8_SB(1, 1), b3 + hstep, voffB);
            PG8_WAIT_V(6); PG8_WAIT_L(0); PG8_BAR; PG8_MMA(1, 0, At, B0); PG8_MMA(1, 1, At, B1); PG8_BAR; PG8_SCHED;
        }
        if (wr == 0) PG8_BAR;
        const bool keep = E(acc, cur, wr, wc, fr, fq);
        if (!has_next) break;
        if (!keep) {
#pragma unroll
            for (int a = 0; a < 2; ++a)
#pragma unroll
                for (int b = 0; b < 2; ++b)
#pragma unroll
                    for (int m = 0; m < 4; ++m)
#pragma unroll
                        for (int n = 0; n < 2; ++n) acc[a][b][m][n] = (f32x4){0.f, 0.f, 0.f, 0.f};
        }
        cur = nxt; cA = nA; cB = nB; ++ui;
        if (wr == 1) PG8_BAR;
    }
    PG8_WAIT_V(0);
    PG8_BAR;
#undef PG8_SA
#undef PG8_SB
#undef PG8_STAGE
#undef PG8_LDA
#undef PG8_LDB
#undef PG8_MMA
#undef PG8_WAIT_V
#undef PG8_WAIT_L
#undef PG8_BAR
#undef PG8_SCHED
}

struct EpiProj {
    unsigned char* ws; LAS unsigned char* lds;
    __device__ __forceinline__ bool operator()(f32x4 (&acc)[2][2][4][2], const Unit& u, int wr, int wc, int fr, int fq) const {
        const int pn = u.pn; const int row0 = u.pm * BM + wr * 64 + fr;
        if (pn < 5) {
            const float* rope = (const float*)(ws + WS_ROPE);
            const bool isq = pn < 4;
            bf16_t* O = (bf16_t*)(ws + (isq ? WS_Q : WS_K)); const int ldo = isq ? 1024 : 256, hcol = isq ? (pn * 4 + wc) * 64 : wc * 64; const float sc = isq ? 0.125f : 1.0f;
#pragma unroll
            for (int ai = 0; ai < 2; ++ai) {
                f32x4 tb[4][4];
#pragma unroll
                for (int m = 0; m < 4; ++m) { const f32x4* rp = (const f32x4*)(rope + (size_t)(row0 + ai * HALF + m * 16) * 64 + 8 * fq); tb[m][0] = rp[0]; tb[m][1] = rp[1]; tb[m][2] = rp[8]; tb[m][3] = rp[9]; }
#pragma unroll
                for (int m = 0; m < 4; ++m) {
                    const int row = row0 + ai * HALF + m * 16;
                    const f32x4 c0 = tb[m][0], c1 = tb[m][1], s0 = tb[m][2], s1 = tb[m][3];
                    const f32x4 x1a = acc[ai][0][m][0], x1b = acc[ai][0][m][1], x2a = acc[ai][1][m][0], x2b = acc[ai][1][m][1];
                    const f32x4 o1a = (x1a * c0 - x2a * s0) * sc, o1b = (x1b * c1 - x2b * s1) * sc;
                    const f32x4 o2a = (x2a * c0 + x1a * s0) * sc, o2b = (x2b * c1 + x1b * s1) * sc;
                    bf16_t* op = O + (size_t)row * ldo + hcol + 8 * fq;
                    *(u32x4*)op = pack8(o1a, o1b); *(u32x4*)(op + 32) = pack8(o2a, o2b);
                }
            }
        } else if (pn == 5 || (pn >= 14 && pn < 18)) {
            bf16_t* O = (bf16_t*)(ws + ((pn == 5) ? WS_VT : WS_HVT + (size_t)(pn - 14) * 256 * T * 2));
            LAS unsigned char* xl = lds + 131072 + (wr * 4 + wc) * 3456;
            const int lane = fr + 16 * fq;
#pragma unroll
            for (int ai = 0; ai < 2; ++ai)
#pragma unroll
                for (int bj = 0; bj < 2; ++bj)
#pragma unroll
                    for (int p = 0; p < 2; ++p) {
#pragma unroll
                        for (int mm = 0; mm < 2; ++mm)
#pragma unroll
                            for (int n = 0; n < 2; ++n)
#pragma unroll
                                for (int i = 0; i < 4; ++i)
                                    *(LAS bf16_t*)(xl + (8 * fq + 4 * n + i) * 80 + (16 * mm + fr) * 2) = (bf16_t)f2bf(acc[ai][bj][2 * p + mm][n][i]);
                        asm volatile("s_waitcnt lgkmcnt(0)" ::: "memory");
#pragma unroll
                        for (int h2 = 0; h2 < 2; ++h2) {
                            const int cl = (lane >> 2) + 16 * h2, chk = lane & 3;
                            const u32x4 v = *(const LAS u32x4*)(xl + cl * 80 + chk * 16);
                            *(u32x4*)(O + (size_t)(bj * HALF + wc * 32 + cl) * T + u.pm * BM + ai * HALF + wr * 64 + 32 * p + 8 * chk) = v;
                        }
                        asm volatile("s_waitcnt lgkmcnt(0)" ::: "memory");
                    }
        } else {
            size_t ooff; int ldo, cb; int mode;
            if (pn < 10) { ooff = WS_HQ; ldo = 1024; cb = (pn - 6) * 256; mode = 3; }
            else if (pn < 14) { ooff = WS_HZ; ldo = 1024; cb = (pn - 10) * 256; mode = 0; }
            else if (pn < 22) { ooff = WS_HG; ldo = 1024; cb = (pn - 18) * 256; mode = 2; }
            else if (pn < 30) { ooff = WS_GSA; ldo = 2048; cb = (pn - 22) * 256; mode = 1; }
            else { ooff = WS_GSB; ldo = 2048; cb = (pn - 30) * 256; mode = 1; }
            bf16_t* O = (bf16_t*)(ws + ooff);
            const float osc = (mode == 3) ? 0.08838834764831845f : 1.0f;
#pragma unroll
            for (int ai = 0; ai < 2; ++ai)
#pragma unroll
                for (int m = 0; m < 4; ++m) {
                    bf16_t* rowp = O + (size_t)(row0 + ai * HALF + m * 16) * ldo + cb + wc * 32 + 8 * fq;
#pragma unroll
                    for (int bj = 0; bj < 2; ++bj) {
                        f32x4 v[2] = {acc[ai][bj][m][0], acc[ai][bj][m][1]};
#pragma unroll
                        for (int n = 0; n < 2; ++n)
#pragma unroll
                            for (int i = 0; i < 4; ++i) { const float x = v[n][i]; const float s = sigmoidf_(x); v[n][i] = (mode == 0) ? x : (mode == 1) ? s : x * s * osc; }
                        *(u32x4*)(rowp + bj * HALF) = pack8(v[0], v[1]);
                    }
                }
        }
        return false;
    }
};
struct EpiMerged {
    const bf16_t *GSA, *GSB; bf16_t* O;
    __device__ __forceinline__ bool operator()(f32x4 (&acc)[2][2][4][2], const Unit& u, int wr, int wc, int fr, int fq) const {
        const int row0 = u.pm * BM + wr * 64 + fr, col0 = u.pn * BM + wc * 32 + 8 * fq;
#pragma unroll
        for (int ai = 0; ai < 2; ++ai) {
            u32x4 gb[4][2], ga[4][2];
#pragma unroll
            for (int m = 0; m < 4; ++m)
#pragma unroll
                for (int bj = 0; bj < 2; ++bj) {
                    const size_t off = (size_t)(row0 + ai * HALF + m * 16) * DM + col0 + bj * HALF;
                    gb[m][bj] = *(const u32x4*)(GSB + off);
                    if (u.half == 0) ga[m][bj] = *(const u32x4*)(GSA + off);
                }
#pragma unroll
            for (int m = 0; m < 4; ++m)
#pragma unroll
                for (int bj = 0; bj < 2; ++bj) {
                    const size_t off = (size_t)(row0 + ai * HALF + m * 16) * DM + col0 + bj * HALF;
                    const u32x4 sb = gb[m][bj];
                    const float fb[8] = {bflo(sb.x), bfhi(sb.x), bflo(sb.y), bfhi(sb.y), bflo(sb.z), bfhi(sb.z), bflo(sb.w), bfhi(sb.w)};
                    if (u.half == 0) {
                        const u32x4 sa = ga[m][bj];
                        const float fa[8] = {bflo(sa.x), bfhi(sa.x), bflo(sa.y), bfhi(sa.y), bflo(sa.z), bfhi(sa.z), bflo(sa.w), bfhi(sa.w)};
#pragma unroll
                        for (int n = 0; n < 2; ++n)
#pragma unroll
                            for (int i = 0; i < 4; ++i) acc[ai][bj][m][n][i] *= fa[4 * n + i] * __builtin_amdgcn_rcpf(fb[4 * n + i]);
                    } else {
                        f32x4 v0, v1;
#pragma unroll
                        for (int i = 0; i < 4; ++i) { v0[i] = acc[ai][bj][m][0][i] * fb[i]; v1[i] = acc[ai][bj][m][1][i] * fb[4 + i]; }
                        *(u32x4*)(O + off) = pack8(v0, v1);
                    }
                }
        }
        return u.half == 0;
    }
};
struct EpiRowSS {
    float* Y; float* part;
    __device__ __forceinline__ bool operator()(f32x4 (&acc)[2][2][4][2], const Unit& u, int wr, int wc, int fr, int fq) const {
        const int row0 = u.pm * BM + wr * 64 + fr, col0 = u.pn * BM + wc * 32 + 8 * fq;
#pragma unroll
        for (int ai = 0; ai < 2; ++ai)
#pragma unroll
            for (int m = 0; m < 4; ++m) {
                const int row = row0 + ai * HALF + m * 16; float ss = 0.f;
#pragma unroll
                for (int bj = 0; bj < 2; ++bj) {
                    const f32x4 v0 = acc[ai][bj][m][0], v1 = acc[ai][bj][m][1];
                    float* yp = Y + (size_t)row * DM + col0 + bj * HALF;
                    *(f32x4*)yp = v0; *(f32x4*)(yp + 4) = v1;
                    ss += (v0[0] * v0[0] + v0[1] * v0[1]) + (v0[2] * v0[2] + v0[3] * v0[3]) + (v1[0] * v1[0] + v1[1] * v1[1]) + (v1[2] * v1[2] + v1[3] * v1[3]);
                }
                ss += __shfl_xor(ss, 16); ss += __shfl_xor(ss, 32);
                if (fq == 0) part[(size_t)row * 32 + u.pn * 4 + wc] = ss;
            }
        return false;
    }
};
struct EpiRowSSb {
    bf16_t* Y; float* part;
    __device__ __forceinline__ bool operator()(f32x4 (&acc)[2][2][4][2], const Unit& u, int wr, int wc, int fr, int fq) const {
        const int row0 = u.pm * BM + wr * 64 + fr, col0 = u.pn * BM + wc * 32 + 8 * fq;
#pragma unroll
        for (int ai = 0; ai < 2; ++ai)
#pragma unroll
            for (int m = 0; m < 4; ++m) {
                const int row = row0 + ai * HALF + m * 16; float ss = 0.f;
#pragma unroll
                for (int bj = 0; bj < 2; ++bj) {
                    const f32x4 v0 = acc[ai][bj][m][0], v1 = acc[ai][bj][m][1];
                    *(u32x4*)(Y + (size_t)row * DM + col0 + bj * HALF) = pack8(v0, v1);
                    ss += (v0[0] * v0[0] + v0[1] * v0[1]) + (v0[2] * v0[2] + v0[3] * v0[3]) + (v1[0] * v1[0] + v1[1] * v1[1]) + (v1[2] * v1[2] + v1[3] * v1[3]);
                }
                ss += __shfl_xor(ss, 16); ss += __shfl_xor(ss, 32);
                if (fq == 0) part[(size_t)row * 32 + u.pn * 4 + wc] = ss;
            }
        return false;
    }
};
struct EpiSwiglu {
    bf16_t* O;
    __device__ __forceinline__ bool operator()(f32x4 (&acc)[2][2][4][2], const Unit& u, int wr, int wc, int fr, int fq) const {
        const int row0 = u.pm * BM + wr * 64 + fr, col0 = u.pn * HALF + wc * 32 + 8 * fq;
#pragma unroll
        for (int ai = 0; ai < 2; ++ai)
#pragma unroll
            for (int m = 0; m < 4; ++m) {
                f32x4 v[2];
#pragma unroll
                for (int n = 0; n < 2; ++n)
#pragma unroll
                    for (int i = 0; i < 4; ++i) { const float gx = acc[ai][0][m][n][i]; v[n][i] = gx * sigmoidf_(gx) * acc[ai][1][m][n][i]; }
                *(u32x4*)(O + (size_t)(row0 + ai * HALF + m * 16) * DFF + col0) = pack8(v[0], v[1]);
            }
        return false;
    }
};
struct EpiE0 {
    bf16_t* E0;
    __device__ __forceinline__ bool operator()(f32x4 (&acc)[2][2][4][2], const Unit& u, int wr, int wc, int fr, int fq) const {
        const int row0 = u.pm * BM + wr * 64 + fr, col0 = u.pn * BM + wc * 32 + 8 * fq;
#pragma unroll
        for (int ai = 0; ai < 2; ++ai)
#pragma unroll
            for (int m = 0; m < 4; ++m)
#pragma unroll
                for (int bj = 0; bj < 2; ++bj)
                    *(u32x4*)(E0 + (size_t)(row0 + ai * HALF + m * 16) * DM + col0 + bj * HALF) = pack8(acc[ai][bj][m][0], acc[ai][bj][m][1]);
        return false;
    }
};
struct EpiPle {
    const bf16_t* E0; bf16_t* Y; float* part;
    __device__ __forceinline__ bool operator()(f32x4 (&acc)[2][2][4][2], const Unit& u, int wr, int wc, int fr, int fq) const {
        const int row0 = u.pm * BM + wr * 64 + fr, col0 = u.pn * BM + wc * 32 + 8 * fq;
#pragma unroll
        for (int ai = 0; ai < 2; ++ai)
#pragma unroll
            for (int m = 0; m < 4; ++m) {
                const int row = row0 + ai * HALF + m * 16; float ss = 0.f;
#pragma unroll
                for (int bj = 0; bj < 2; ++bj) {
                    const size_t off = (size_t)row * DM + col0 + bj * HALF;
                    const u32x4 eb = *(const u32x4*)(E0 + off);
                    const float fe[8] = {bflo(eb.x), bfhi(eb.x), bflo(eb.y), bfhi(eb.y), bflo(eb.z), bfhi(eb.z), bflo(eb.w), bfhi(eb.w)};
                    f32x4 v[2];
#pragma unroll
                    for (int n = 0; n < 2; ++n)
#pragma unroll
                        for (int i = 0; i < 4; ++i) { const float e = fe[4 * n + i] * sigmoidf_(acc[ai][bj][m][n][i]); v[n][i] = e; ss += e * e; }
                    *(u32x4*)(Y + off) = pack8(v[0], v[1]);
                }
                ss += __shfl_xor(ss, 16); ss += __shfl_xor(ss, 32);
                if (fq == 0) part[(size_t)row * 32 + u.pn * 4 + wc] = ss;
            }
        return false;
    }
};
}

__device__ __forceinline__ void transpose_item(const float* W, int N, bf16_t* WT, int dst_ld, int dst_row0, int dst_k0, int k0, int n0, LAS float* scr, int lane) {
#pragma unroll 8
    for (int i = 0; i < 32; ++i) { const int kk = 2 * i + (lane >> 5); scr[kk * 33 + (lane & 31)] = W[(size_t)(k0 + kk) * N + n0 + (lane & 31)]; }
    asm volatile("s_waitcnt lgkmcnt(0)" ::: "memory");
    const int c = lane & 7;
#pragma unroll
    for (int j = 0; j < 4; ++j) { const int n = (lane >> 3) + 8 * j; const LAS float* s = scr + (8 * c) * 33 + n;
        u32x4 o; o.x = pk2(s[0 * 33], s[1 * 33]); o.y = pk2(s[2 * 33], s[3 * 33]); o.z = pk2(s[4 * 33], s[5 * 33]); o.w = pk2(s[6 * 33], s[7 * 33]);
        *(u32x4*)(WT + (size_t)(dst_row0 + n) * dst_ld + dst_k0 + 8 * c) = o; }
    asm volatile("s_waitcnt lgkmcnt(0)" ::: "memory");
}
__device__ __forceinline__ void rms_row_to_bf16(const float* xrow, const float* gain, bf16_t* orow, int lane) {
    const f32x4* xr = (const f32x4*)xrow + lane; const f32x4* gr = (const f32x4*)gain + lane;
    f32x4 v[8]; float s = 0.f;
#pragma unroll
    for (int j = 0; j < 8; ++j) { v[j] = xr[64 * j]; s += (v[j][0] * v[j][0] + v[j][1] * v[j][1]) + (v[j][2] * v[j][2] + v[j][3] * v[j][3]); }
    const float rstd = rsqrtf(wave_sum(s) * (1.0f / DM) + RMS_EPS);
    u32x2* o8 = (u32x2*)orow + lane;
#pragma unroll
    for (int j = 0; j < 8; ++j) { const f32x4 g = gr[64 * j]; u32x2 w; w.x = pk2(v[j][0] * rstd * g[0], v[j][1] * rstd * g[1]); w.y = pk2(v[j][2] * rstd * g[2], v[j][3] * rstd * g[3]); o8[64 * j] = w; }
}
template <bool XIB, bool XOB> __device__ __forceinline__ void rowpass(const bf16_t* Y, const float* part, const void* Xin, void* Xout, const float* g_post, const float* g_pre, bf16_t* Hout, int gw, int ngw, int lane_) {
    int lane = lane_; asm volatile("" : "+v"(lane));
    f32x4 gp[8];
#pragma unroll
    for (int j = 0; j < 8; ++j) gp[j] = ((const f32x4*)g_post)[lane + 64 * j];
    u32x2 ny[8]; f32x4 nxf[8]; u32x2 nxb[8]; float np = 0.f;
#define RP_LOAD(r) do { np = part[(size_t)(r) * 32 + (lane & 31)]; \
        const u32x2* yb_ = (const u32x2*)(Y + (size_t)(r) * DM) + lane; \
        _Pragma("unroll") for (int j = 0; j < 8; ++j) { ny[j] = yb_[64 * j]; \
            if (XIB) nxb[j] = ((const u32x2*)((const bf16_t*)Xin + (size_t)(r) * DM) + lane)[64 * j]; else nxf[j] = ((const f32x4*)((const float*)Xin + (size_t)(r) * DM) + lane)[64 * j]; } } while (0)
    int row = gw;
    if (row < T) RP_LOAD(row);
    for (; row < T; row += ngw) {
        u32x2 cy[8]; f32x4 cx[8]; float p = np;
#pragma unroll
        for (int j = 0; j < 8; ++j) { cy[j] = ny[j]; if (XIB) cx[j] = (f32x4){bflo(nxb[j].x), bfhi(nxb[j].x), bflo(nxb[j].y), bfhi(nxb[j].y)}; else cx[j] = nxf[j]; }
        if (row + ngw < T) RP_LOAD(row + ngw);
#pragma unroll
        for (int o = 1; o < 32; o <<= 1) p += __shfl_xor(p, o);
        const float rstd = rsqrtf(p * (1.0f / DM) + RMS_EPS);
        f32x4* of = (f32x4*)((float*)Xout + (size_t)row * DM) + lane; u32x2* ob = (u32x2*)((bf16_t*)Xout + (size_t)row * DM) + lane;
        f32x4 v[8]; float s = 0.f;
#pragma unroll
        for (int j = 0; j < 8; ++j) {
            const f32x4 y = {bflo(cy[j].x), bfhi(cy[j].x), bflo(cy[j].y), bfhi(cy[j].y)};
            v[j] = cx[j] + y * rstd * gp[j];
            if (XOB) { u32x2 o2; o2.x = pk2(v[j][0], v[j][1]); o2.y = pk2(v[j][2], v[j][3]); ob[64 * j] = o2; } else of[64 * j] = v[j];
            s += (v[j][0] * v[j][0] + v[j][1] * v[j][1]) + (v[j][2] * v[j][2] + v[j][3] * v[j][3]);
        }
        if (Hout) {
            const float r2 = rsqrtf(wave_sum(s) * (1.0f / DM) + RMS_EPS);
            const f32x4* gq = (const f32x4*)g_pre + lane; u32x2* o8 = (u32x2*)(Hout + (size_t)row * DM) + lane;
#pragma unroll
            for (int j = 0; j < 8; ++j) { const f32x4 g = gq[64 * j]; u32x2 w; w.x = pk2(v[j][0] * r2 * g[0], v[j][1] * r2 * g[1]); w.y = pk2(v[j][2] * r2 * g[2], v[j][3] * r2 * g[3]); o8[64 * j] = w; }
        }
    }
#undef RP_LOAD
}

#define LDS_BAR do { asm volatile("s_waitcnt lgkmcnt(0)" ::: "memory"); __builtin_amdgcn_s_barrier(); asm volatile("" ::: "memory"); } while (0)
__device__ __forceinline__ void attn_units(LAS unsigned char* lds, const bf16_t* Q, const bf16_t* Kk, const bf16_t* VT, const float* sinks, bf16_t* Y, int bid, int G, int tid) {
    const int lane = tid & 63, wave = tid >> 6, g = lane >> 4, n = lane & 15;
    LAS bf16_t* KL = (LAS bf16_t*)lds;
    LAS bf16_t* VL = (LAS bf16_t*)(lds + 36864);
    for (int it = bid; it < 512; it += G) {
        const int kvh = it & 3, blk = (it >> 2) & 63, b = it >> 8, s0 = blk * 128 + wave * 16, ks = blk * 128 - 128; const size_t tokb = (size_t)b * SEQ;
        u32x4 kst[4], vst[4];
#pragma unroll
        for (int ps = 0; ps < 4; ++ps) { const int row = ps * 64 + (tid >> 3), kr = ks + row; kst[ps] = *(const u32x4*)(Kk + (tokb + (kr < 0 ? 0 : kr)) * 256 + kvh * 64 + 8 * (tid & 7)); }
#pragma unroll
        for (int ps = 0; ps < 4; ++ps) { const int row = ps * 16 + (tid >> 5), kc = ks + 8 * (tid & 31); vst[ps] = *(const u32x4*)(VT + (size_t)(kvh * 64 + row) * T + tokb + (kc < 0 ? 0 : kc)); }
        const bf16_t* qp = Q + (tokb + s0 + n) * 1024 + (kvh * 4) * 64 + 8 * g;
        bf16x8 qf[2];
        qf[0] = *(const bf16x8*)qp; qf[1] = *(const bf16x8*)(qp + 32);
#pragma unroll
        for (int ps = 0; ps < 4; ++ps) *(LAS u32x4*)(KL + (ps * 64 + (tid >> 3)) * 72 + 8 * (tid & 7)) = kst[ps];
#pragma unroll
        for (int ps = 0; ps < 4; ++ps) *(LAS u32x4*)(VL + (ps * 16 + (tid >> 5)) * 264 + 8 * (tid & 31)) = vst[ps];
        __syncthreads();
        bf16x8 kf[9][2];
#pragma unroll
        for (int j = 0; j < 9; ++j) { const LAS bf16_t* kp = KL + (16 * wave + 16 * j + n) * 72 + 8 * g; kf[j][0] = *(const LAS bf16x8*)kp; kf[j][1] = *(const LAS bf16x8*)(kp + 32); }
        bf16x8 pf[4][5]; float inv[4];
#pragma unroll
        for (int hh = 0; hh < 4; ++hh) {
            f32x4 sc[9];
#pragma unroll
            for (int j = 0; j < 9; ++j) { f32x4 a = {0.f, 0.f, 0.f, 0.f}; a = mfma16(kf[j][0], qf[0], a); a = mfma16(kf[j][1], qf[1], a); sc[j] = a; }
            if (hh < 3) { qf[0] = *(const bf16x8*)(qp + (hh + 1) * 64); qf[1] = *(const bf16x8*)(qp + (hh + 1) * 64 + 32); }
            const float sink = sinks[kvh * 4 + hh];
            float mx = sink;
#pragma unroll
            for (int j = 0; j < 9; ++j) {
                const int key0 = s0 - 128 + 16 * j;
#pragma unroll
                for (int i = 0; i < 4; ++i) {
                    const int kr = 4 * g + i;
                    bool valid = key0 >= 0;
                    if (j == 0) valid = valid && (kr >= n + 1);
                    if (j == 8) valid = valid && (kr <= n);
                    const float v = valid ? sc[j][i] : -1e30f;
                    sc[j][i] = v; mx = fmaxf(mx, v);
                }
            }
            mx = fmaxf(mx, __shfl_xor(mx, 16)); mx = fmaxf(mx, __shfl_xor(mx, 32));
            float l = 0.f;
#pragma unroll
            for (int j = 0; j < 9; ++j)
#pragma unroll
                for (int i = 0; i < 4; ++i) { const float p = __expf(sc[j][i] - mx); sc[j][i] = p; l += p; }
            l += __shfl_xor(l, 16); l += __shfl_xor(l, 32);
            l += __expf(sink - mx);
            inv[hh] = 1.0f / l;
#pragma unroll
            for (int ks5 = 0; ks5 < 5; ++ks5) {
                const f32x4 pa = sc[2 * ks5]; const f32x4 pb = (2 * ks5 + 1 < 9) ? sc[(2 * ks5 + 1 < 9) ? 2 * ks5 + 1 : 0] : (f32x4){0.f, 0.f, 0.f, 0.f};
                u32x4 w; w.x = pk2_sw(pa[0], pa[1]); w.y = pk2_sw(pa[2], pa[3]); w.z = pk2_sw(pb[0], pb[1]); w.w = pk2_sw(pb[2], pb[3]);
                pf[hh][ks5] = __builtin_bit_cast(bf16x8, w);
            }
        }
#pragma unroll
        for (int dt = 0; dt < 4; ++dt) {
            const LAS bf16_t* vrow = VL + (dt * 16 + n) * 264 + 16 * wave + 4 * g;
            bf16x8 vf[5];
#pragma unroll
            for (int ks5 = 0; ks5 < 5; ++ks5) {
                const u32x2 va = *(const LAS u32x2*)(vrow + 32 * ks5);
                u32x2 vb = {0u, 0u}; if (ks5 < 4) vb = *(const LAS u32x2*)(vrow + 32 * ks5 + 16);
                u32x4 w; w.x = va.x; w.y = va.y; w.z = vb.x; w.w = vb.y; vf[ks5] = __builtin_bit_cast(bf16x8, w);
            }
#pragma unroll
            for (int hh = 0; hh < 4; ++hh) {
                f32x4 acc = {0.f, 0.f, 0.f, 0.f};
#pragma unroll
                for (int ks5 = 0; ks5 < 5; ++ks5) acc = mfma16(vf[ks5], pf[hh][ks5], acc);
                u32x2 o; o.x = pk2_sw(acc[0] * inv[hh], acc[1] * inv[hh]); o.y = pk2_sw(acc[2] * inv[hh], acc[3] * inv[hh]);
                *(u32x2*)(Y + (tokb + s0 + n) * DM + (kvh * 4 + hh) * 64 + dt * 16 + 4 * g) = o;
            }
        }
        __syncthreads();
    }
}

__device__ __forceinline__ void hgrn_passA_units(LAS unsigned char* lds, const bf16_t* HZ, const bf16_t* HVT, const float* LB, bf16_t* U, float* DC, int bid, int G, int tid) {
    const int k = tid & 127, I = tid >> 7, lane = tid & 63, w = tid >> 6, g = lane >> 4, n = lane & 15;
    LAS float* TOT = (LAS float*)lds;
    LAS bf16_t* KT = (LAS bf16_t*)(lds + 2048);
    LAS bf16_t* VS = (LAS bf16_t*)(lds + 2048 + 18432);
#define PA_DECODE(r_) const int h = (r_) & 7, c = ((r_) >> 3) & 127, b = (r_) >> 10; const size_t tok0 = (size_t)b * SEQ + (size_t)c * 64; const int ch = (b * 8 + h) * 128 + c;
#define PA_LOADZ(r_) do { PA_DECODE(r_) (void)ch; _Pragma("unroll") for (int i = 0; i < 16; ++i) zn[i] = HZ[(tok0 + 16 * I + i) * 1024 + h * 128 + k]; } while (0)
    unsigned short zn[16];
    int r = bid;
    if (r >= 2048) return;
    PA_LOADZ(r);
    for (; r < 2048; r += G) {
        PA_DECODE(r)
        const float lb = LB[h * 128 + k], oml = 1.0f - lb;
        unsigned short zc[16];
#pragma unroll
        for (int i = 0; i < 16; ++i) zc[i] = zn[i];
        u32x4 vst[2];
#pragma unroll
        for (int ps = 0; ps < 2; ++ps) vst[ps] = *(const u32x4*)(HVT + (size_t)(h * 128 + 64 * ps + (tid >> 3)) * T + tok0 + 8 * (tid & 7));
        if (r + G < 2048) PA_LOADZ(r + G);
        float cs[16], kk[16]; float run = 0.f;
#pragma unroll
        for (int i = 0; i < 16; ++i) {
            const float z = bf2f(zc[i]);
            const float e = __expf(-z), s = __builtin_amdgcn_rcpf(1.0f + e);
            run += __logf(lb + oml * s); cs[i] = run; kk[i] = oml * e * s;
        }
        TOT[I * 128 + k] = run;
        LDS_BAR;
        const float t0 = TOT[k], t1 = TOT[128 + k], t2 = TOT[256 + k], t3 = TOT[384 + k];
        const float rI = (I > 0 ? t0 : 0.f) + (I > 1 ? t1 : 0.f) + (I > 2 ? t2 : 0.f);
        const float blast = (t0 + t1) + (t2 + t3);
        unsigned pw[8];
#pragma unroll
        for (int i = 0; i < 8; ++i) pw[i] = pk2(kk[2 * i] * __expf(blast - rI - cs[2 * i]), kk[2 * i + 1] * __expf(blast - rI - cs[2 * i + 1]));
        LAS u32x4* kd = (LAS u32x4*)(KT + k * 72 + 16 * I);
        kd[0] = (u32x4){pw[0], pw[1], pw[2], pw[3]}; kd[1] = (u32x4){pw[4], pw[5], pw[6], pw[7]};
        if (I == 0) DC[(size_t)ch * 128 + k] = __expf(blast);
#pragma unroll
        for (int ps = 0; ps < 2; ++ps) *(LAS u32x4*)(VS + (64 * ps + (tid >> 3)) * 72 + 8 * (tid & 7)) = vst[ps];
        LDS_BAR;
        f32x4 acc[8];
#pragma unroll
        for (int d = 0; d < 8; ++d) acc[d] = (f32x4){0.f, 0.f, 0.f, 0.f};
#pragma unroll
        for (int st = 0; st < 2; ++st) {
            const bf16x8 a = *(const LAS bf16x8*)(KT + (16 * w + n) * 72 + 32 * st + 8 * g);
#pragma unroll
            for (int d = 0; d < 8; ++d) acc[d] = mfma16(a, *(const LAS bf16x8*)(VS + (16 * d + n) * 72 + 32 * st + 8 * g), acc[d]);
        }
#pragma unroll
        for (int d = 0; d < 8; ++d) { u32x2 o; o.x = pk2(acc[d][0], acc[d][1]); o.y = pk2(acc[d][2], acc[d][3]); *(u32x2*)(U + (size_t)ch * 16384 + (size_t)(16 * d + n) * 128 + 16 * w + 4 * g) = o; }
        LDS_BAR;
    }
#undef PA_DECODE
#undef PA_LOADZ
}

__device__ __forceinline__ void hgrn_passC(LAS unsigned char* lds, const bf16_t* HQ, const bf16_t* HZ, const bf16_t* HVT, const bf16_t* HG, const float* LB, const bf16_t* ST,
                                           const float* gnorm, bf16_t* Y, int b, int c, int h, int tid) {
    const int kp = tid & 63, sb = tid >> 6, I = sb >> 1, hf = sb & 1, lane = tid & 63, w = tid >> 6, g = lane >> 4, n = lane & 15;
    const size_t tok0 = (size_t)b * SEQ + (size_t)c * 64; const int ch = (b * 8 + h) * 128 + c;
    LAS float* TOT = (LAS float*)lds;
    LAS float* SS = (LAS float*)(lds + 4096);
    LAS bf16_t* QE = (LAS bf16_t*)(lds + 4608);
    LAS bf16_t* QI = QE + 64 * 136;
    LAS bf16_t* KB = QI + 64 * 136;
    LAS bf16_t* STS = (LAS bf16_t*)(lds + 82944);
    LAS bf16_t* VS = (LAS bf16_t*)(lds + 117760);
    const f32x2 lb2 = *(const f32x2*)(LB + h * 128 + 2 * kp);
    const int Iw = w & 3, dvh = w >> 2;
    unsigned zr[8], qr[8];
#pragma unroll
    for (int i = 0; i < 8; ++i) { zr[i] = *(const unsigned*)(HZ + (tok0 + 8 * sb + i) * 1024 + h * 128 + 2 * kp); qr[i] = *(const unsigned*)(HQ + (tok0 + 8 * sb + i) * 1024 + h * 128 + 2 * kp); }
    u32x4 sts[4], vst[2]; u32x2 hgv[4];
#pragma unroll
    for (int ps = 0; ps < 4; ++ps) sts[ps] = *(const u32x4*)(ST + (size_t)ch * 16384 + (size_t)(32 * ps + (tid >> 4)) * 128 + 8 * (tid & 15));
#pragma unroll
    for (int ps = 0; ps < 2; ++ps) vst[ps] = *(const u32x4*)(HVT + (size_t)(h * 128 + 64 * ps + (tid >> 3)) * T + tok0 + 8 * (tid & 7));
#pragma unroll
    for (int d4 = 0; d4 < 4; ++d4) hgv[d4] = *(const u32x2*)(HG + (tok0 + 16 * Iw + n) * 1024 + h * 128 + 16 * (4 * dvh + d4) + 4 * g);
    float cs[2][8], kk[2][8]; float run[2] = {0.f, 0.f};
#pragma unroll
    for (int i = 0; i < 8; ++i)
#pragma unroll
        for (int cc = 0; cc < 2; ++cc) {
            const float z = cc ? bfhi(zr[i]) : bflo(zr[i]); const float lb = lb2[cc], oml = 1.0f - lb;
            const float e = __expf(-z), s_ = __builtin_amdgcn_rcpf(1.0f + e);
            run[cc] += __logf(lb + oml * s_); cs[cc][i] = run[cc]; kk[cc][i] = oml * e * s_;
        }
    *(LAS f32x2*)(TOT + sb * 128 + 2 * kp) = (f32x2){run[0], run[1]};
    __syncthreads();
    f32x2 tt[7];
#pragma unroll
    for (int j = 0; j < 7; ++j) tt[j] = *(const LAS f32x2*)(TOT + j * 128 + 2 * kp);
    float eI[2], fI[2][4], pre[2];
#pragma unroll
    for (int cc = 0; cc < 2; ++cc) {
        const float r1 = tt[0][cc] + tt[1][cc], r2 = r1 + tt[2][cc] + tt[3][cc], r3 = r2 + tt[4][cc] + tt[5][cc];
        const float rI = (I == 0) ? 0.f : (I == 1) ? r1 : (I == 2) ? r2 : r3;
        const float tfirst = (I == 0) ? tt[0][cc] : (I == 1) ? tt[2][cc] : (I == 2) ? tt[4][cc] : tt[6][cc];
        pre[cc] = hf ? tfirst : 0.f;
        eI[cc] = __expf(rI);
        fI[cc][0] = __expf(0.f - rI); fI[cc][1] = __expf(r1 - rI); fI[cc][2] = __expf(r2 - rI); fI[cc][3] = __expf(r3 - rI);
    }
#pragma unroll
    for (int i = 0; i < 8; ++i) {
        const int t = 8 * sb + i, rowb = 8 * hf + i;
        float qi[2], kinv[2];
#pragma unroll
        for (int cc = 0; cc < 2; ++cc) { const float ecs = __expf(pre[cc] + cs[cc][i]); qi[cc] = (cc ? bfhi(qr[i]) : bflo(qr[i])) * ecs; kinv[cc] = kk[cc][i] * __builtin_amdgcn_rcpf(ecs); }
        *(LAS unsigned*)(QE + t * 136 + 2 * kp) = cvtpk_(qi[0] * eI[0], qi[1] * eI[1]);
        *(LAS unsigned*)(QI + t * 136 + 2 * kp) = cvtpk_(qi[0], qi[1]);
#pragma unroll
        for (int Ip = 0; Ip < 4; ++Ip) {
            if (Ip >= I) {
                const int blk = Ip * (Ip + 1) / 2 + I;
                *(LAS unsigned*)(KB + (blk * 16 + rowb) * 136 + 2 * kp) = cvtpk_(kinv[0] * fI[0][Ip], kinv[1] * fI[1][Ip]);
            }
        }
    }
#pragma unroll
    for (int ps = 0; ps < 4; ++ps) *(LAS u32x4*)(STS + (32 * ps + (tid >> 4)) * 136 + 8 * (tid & 15)) = sts[ps];
#pragma unroll
    for (int ps = 0; ps < 2; ++ps) *(LAS u32x4*)(VS + (64 * ps + (tid >> 3)) * 72 + 8 * (tid & 7)) = vst[ps];
    __syncthreads();
    f32x4 at[4];
#pragma unroll
    for (int J = 0; J < 4; ++J) {
        f32x4 a4 = {0.f, 0.f, 0.f, 0.f};
        if (J <= Iw) {
            const int blk = Iw * (Iw + 1) / 2 + J;
#pragma unroll
            for (int st = 0; st < 4; ++st) {
                const bf16x8 a = *(const LAS bf16x8*)(KB + (blk * 16 + n) * 136 + 32 * st + 8 * g);
                const bf16x8 bq = *(const LAS bf16x8*)(QI + (16 * Iw + n) * 136 + 32 * st + 8 * g);
                a4 = mfma16(a, bq, a4);
            }
            if (J == Iw) {
#pragma unroll
                for (int i = 0; i < 4; ++i) if (4 * g + i > n) a4[i] = 0.f;
            }
        }
        at[J] = a4;
    }
    bf16x8 pf[2];
#pragma unroll
    for (int ks = 0; ks < 2; ++ks) { u32x4 wv; wv.x = pk2(at[2 * ks][0], at[2 * ks][1]); wv.y = pk2(at[2 * ks][2], at[2 * ks][3]); wv.z = pk2(at[2 * ks + 1][0], at[2 * ks + 1][1]); wv.w = pk2(at[2 * ks + 1][2], at[2 * ks + 1][3]);
        pf[ks] = __builtin_bit_cast(bf16x8, wv); }
    f32x4 o[4]; float ss = 0.f;
#pragma unroll
    for (int d4 = 0; d4 < 4; ++d4) {
        f32x4 acc = {0.f, 0.f, 0.f, 0.f};
#pragma unroll
        for (int st = 0; st < 4; ++st) {
            const bf16x8 bq = *(const LAS bf16x8*)(QE + (16 * Iw + n) * 136 + 32 * st + 8 * g);
            acc = mfma16(*(const LAS bf16x8*)(STS + (16 * (4 * dvh + d4) + n) * 136 + 32 * st + 8 * g), bq, acc);
        }
        const LAS bf16_t* vl = VS + (16 * (4 * dvh + d4) + n) * 72 + 4 * g;
        { const u32x2 v0 = *(const LAS u32x2*)vl, v1 = *(const LAS u32x2*)(vl + 16); u32x4 wv; wv.x = v0.x; wv.y = v0.y; wv.z = v1.x; wv.w = v1.y; acc = mfma16(__builtin_bit_cast(bf16x8, wv), pf[0], acc); }
        { const u32x2 v0 = *(const LAS u32x2*)(vl + 32), v1 = *(const LAS u32x2*)(vl + 48); u32x4 wv; wv.x = v0.x; wv.y = v0.y; wv.z = v1.x; wv.w = v1.y; acc = mfma16(__builtin_bit_cast(bf16x8, wv), pf[1], acc); }
        o[d4] = acc; ss += (acc[0] * acc[0] + acc[1] * acc[1]) + (acc[2] * acc[2] + acc[3] * acc[3]);
    }
    ss += __shfl_xor(ss, 16); ss += __shfl_xor(ss, 32);
    if (g == 0) SS[dvh * 64 + 16 * Iw + n] = ss;
    __syncthreads();
    const float tot = SS[16 * Iw + n] + SS[64 + 16 * Iw + n];
    const float rstd = rsqrtf(tot * (1.0f / 128.0f) + RMS_EPS);
#pragma unroll
    for (int d4 = 0; d4 < 4; ++d4) {
        const int dv = 16 * (4 * dvh + d4) + 4 * g;
        const f32x4 gn = *(const f32x4*)(gnorm + dv);
        const u32x2 hg = hgv[d4];
        u32x2 ov; ov.x = pk2(o[d4][0] * rstd * gn[0] * bflo(hg.x), o[d4][1] * rstd * gn[1] * bfhi(hg.x)); ov.y = pk2(o[d4][2] * rstd * gn[2] * bflo(hg.y), o[d4][3] * rstd * gn[3] * bfhi(hg.y));
        *(u32x2*)(Y + (tok0 + 16 * Iw + n) * DM + 1024 + h * 128 + dv) = ov;
    }
    __syncthreads();
}

#define XB_TMO      128
#define XB_XCNT(j)  (256  + 64 * (j))
#define XB_XSUB(j)  (1280 + 64 * (j))
#define XB_XGEN(j)  (2304 + 64 * (j))
#define XB_TOP      3328
#define XB_TOPGEN   3392
#define XCD_BAR_WORDS 3456
#define XB_SPIN_CAP (1u << 18)
__device__ __forceinline__ unsigned xb_ld(unsigned* p)              { return __hip_atomic_load(p, __ATOMIC_RELAXED, __HIP_MEMORY_SCOPE_AGENT); }
__device__ __forceinline__ unsigned xb_add(unsigned* p, unsigned v) { return __hip_atomic_fetch_add(p, v, __ATOMIC_RELAXED, __HIP_MEMORY_SCOPE_AGENT); }
__device__ __forceinline__ unsigned xb_xcc_id() { return (unsigned)__builtin_amdgcn_s_getreg((3 << 11) | 20) & 0xFu; }
#define XB_SPIN(cond, bar) do { unsigned _sp = 0; while (cond) { __builtin_amdgcn_s_sleep(1); \
    if ((++_sp & 255u) == 0u) { if (xb_ld(&(bar)[XB_TMO])) break; if (_sp > XB_SPIN_CAP) { atomicAdd(&(bar)[XB_TMO], 1u); break; } } } } while (0)
__device__ __forceinline__ void xcd_barrier_complete(unsigned* bar, unsigned x, unsigned& nloc, unsigned& nx) {
    const unsigned G = gridDim.x * gridDim.y * gridDim.z;
    unsigned sum, cnt, mine, sp = 0u;
    for (;;) {
        sum = 0u; cnt = 0u; mine = 0u;
#pragma unroll
        for (unsigned j = 0; j < 16; ++j) { const unsigned c = xb_ld(&bar[XB_XCNT(j)]); sum += c; cnt += (c > 0u) ? 1u : 0u; mine = (j == x) ? c : mine; }
        if (sum == G) break;
        __builtin_amdgcn_s_sleep(1);
        if ((++sp & 255u) == 0u) { if (xb_ld(&bar[XB_TMO])) break; if (sp > XB_SPIN_CAP) { atomicAdd(&bar[XB_TMO], 1u); break; } }
    }
    nloc = mine > 0u ? mine : 1u; nx = cnt > 0u ? cnt : 1u;
}
__device__ __forceinline__ void xcd_barrier(unsigned* bar, volatile LAS unsigned* st, bool tid0) {
    asm volatile("s_waitcnt vmcnt(0)" ::: "memory");
    __syncthreads();
    if (tid0) {
        const unsigned x = xb_xcc_id();
        __builtin_amdgcn_s_waitcnt(0);
        unsigned nloc = st[0], nx = st[1];
        if (nloc == 0u) { xcd_barrier_complete(bar, x, nloc, nx); st[0] = nloc; st[1] = nx; }
        const unsigned old = xb_add(&bar[XB_XSUB(x)], 1u);
        const unsigned gen = old / nloc;
        if (old + 1u == (gen + 1u) * nloc) {
            __builtin_amdgcn_fence(__ATOMIC_RELEASE, "agent");
            asm volatile("s_waitcnt vmcnt(0)" ::: "memory");
            const unsigned og = xb_add(&bar[XB_TOP], 1u);
            const unsigned tg = og / nx;
            if (og + 1u == (tg + 1u) * nx) xb_add(&bar[XB_TOPGEN], 1u);
            else XB_SPIN(xb_ld(&bar[XB_TOPGEN]) == tg, bar);
            __builtin_amdgcn_fence(__ATOMIC_ACQUIRE, "agent");
            xb_add(&bar[XB_XGEN(x)], 1u);
            asm volatile("s_waitcnt vmcnt(0)" ::: "memory");
        } else {
            XB_SPIN(xb_ld(&bar[XB_XGEN(x)]) == gen, bar);
            __builtin_amdgcn_fence(__ATOMIC_ACQUIRE, "agent");
            asm volatile("s_waitcnt vmcnt(0)" ::: "memory");
        }
    }
    __syncthreads();
}

__device__ __forceinline__ void counter_barrier(unsigned* cnt, unsigned target, bool tid0) {
    __builtin_amdgcn_fence(__ATOMIC_RELEASE, "agent");
    asm volatile("s_waitcnt vmcnt(0)" ::: "memory");
    __syncthreads();
    if (tid0) {
        __hip_atomic_fetch_add(cnt, 1u, __ATOMIC_RELAXED, __HIP_MEMORY_SCOPE_AGENT);
        while (__hip_atomic_load(cnt, __ATOMIC_RELAXED, __HIP_MEMORY_SCOPE_AGENT) < target) __builtin_amdgcn_s_sleep(2);
    }
    __syncthreads();
    __builtin_amdgcn_fence(__ATOMIC_ACQUIRE, "agent");
    asm volatile("s_waitcnt vmcnt(0)" ::: "memory");
}

#ifndef PHASE_MASK
#define PHASE_MASK 0xFFFFF
#endif
#ifndef REP_MASK
#define REP_MASK 0
#endif
#define PH(k) if constexpr ((PHASE_MASK >> (k)) & 1) _Pragma("nounroll") for (int rep_ = 0; rep_ < ((((REP_MASK) >> (k)) & 1) ? 2 : 1); ++rep_)
constexpr int IT_IN = 32 * 304, IT_GU = 32 * 352, IT_DN = 88 * 64, IT_SQ = 32 * 64, IT_BR = 16 * 64, IT_PP = 4 * 64;
constexpr int IT_REST = IT_DN + 2 * IT_SQ + 2 * IT_BR + IT_PP;
struct Args { const float* in[20]; float* out; unsigned char* ws; };
enum { I_X = 0, I_P, I_POS, I_GMIXPRE, I_WIN, I_SINKS, I_LBL, I_GNORM, I_WATT, I_WHGRN, I_WOUT, I_GMIXPOST, I_GFFNPRE, I_WGU, I_WDN, I_GFFNPOST, I_GPLEPRE, I_WPG, I_WPP, I_GPLEPOST };

__device__ __forceinline__ int my_lane_() { int l; asm volatile("v_mbcnt_lo_u32_b32 %0, -1, 0\n\tv_mbcnt_hi_u32_b32 %0, -1, %0" : "=v"(l)); return l; }
__device__ __forceinline__ void* ldptr(LAS unsigned long long* PT, int k) {
    const unsigned long long v = PT[k];
    const unsigned lo = __builtin_amdgcn_readfirstlane((unsigned)v), hi = __builtin_amdgcn_readfirstlane((unsigned)(v >> 32));
    return (void*)(__attribute__((address_space(1))) void*)(((unsigned long long)hi << 32) | lo);
}
__global__ void __launch_bounds__(512, 2) fwd_megakernel(Args a) {
    extern __shared__ __attribute__((aligned(16))) unsigned char lds_raw[];
    LAS unsigned char* lds = (LAS unsigned char*)lds_raw;
    cg::grid_group grid = cg::this_grid();
    const int G = gridDim.x, bid = blockIdx.x, ngw = G * 8;
    const int wave_s = __builtin_amdgcn_readfirstlane((int)threadIdx.x >> 6);
#define MYLANE my_lane_()
#define MYTID (wave_s * 64 + MYLANE)
#define PH_IDS int tid_l = MYTID; asm volatile("" : "+v"(tid_l)); const int tid = tid_l, lane = tid & 63, wave = __builtin_amdgcn_readfirstlane(tid >> 6), gw = bid * 8 + wave; (void)lane; (void)gw;
    LAS unsigned long long* PT = (LAS unsigned long long*)(lds + LDS_CTL + 64);
    volatile LAS unsigned* XST = (volatile LAS unsigned*)(lds + LDS_CTL);
    if (threadIdx.x == 0) {
#pragma unroll
        for (int i = 0; i < 20; ++i) PT[i] = (unsigned long long)a.in[i];
        PT[20] = (unsigned long long)a.out; PT[21] = (unsigned long long)a.ws;
        XST[0] = 0u; XST[1] = 0u;
        (void)xb_add((unsigned*)a.ws + XB_XCNT(xb_xcc_id()), 1u);
    }
    __syncthreads();
#define GSYNC xcd_barrier((unsigned*)ws, XST, MYTID == 0)
#define LDP(k) ldptr(PT, (k))
#define INF(k) ((const float*)LDP(k))
#define OUTP ((float*)LDP(20))
    unsigned char* ws = (unsigned char*)LDP(21);
#define WIN ((bf16_t*)(ws + WS_WIN))
#define WMRG ((bf16_t*)(ws + WS_WMRG))
#define WOUT ((bf16_t*)(ws + WS_WOUT))
#define WGU ((bf16_t*)(ws + WS_WGU))
#define WDN ((bf16_t*)(ws + WS_WDN))
#define WPG ((bf16_t*)(ws + WS_WPG))
#define WPP ((bf16_t*)(ws + WS_WPP))
#define HB ((bf16_t*)(ws + WS_HB))
#define PB ((bf16_t*)(ws + WS_PB))
#define ROPE ((float*)(ws + WS_ROPE))
#define LB ((float*)(ws + WS_LB))
#define DC ((float*)(ws + WS_DC))
#define PART ((float*)(ws + WS_PART))
#define Qb ((bf16_t*)(ws + WS_Q))
#define Kb ((bf16_t*)(ws + WS_K))
#define VT ((bf16_t*)(ws + WS_VT))
#define HQ ((bf16_t*)(ws + WS_HQ))
#define HZ ((bf16_t*)(ws + WS_HZ))
#define HVT ((bf16_t*)(ws + WS_HVT))
#define HG ((bf16_t*)(ws + WS_HG))
#define GSA ((bf16_t*)(ws + WS_GSA))
#define GSB ((bf16_t*)(ws + WS_GSB))
#define STb ((bf16_t*)(ws + WS_ST))
#define MRG ((bf16_t*)(ws + WS_MRG))
#define ACT ((bf16_t*)(ws + WS_ACT))
#define Y1 ((bf16_t*)(ws + WS_Y1))
#define Y2 ((bf16_t*)(ws + WS_Y2))
#define E0 ((bf16_t*)(ws + WS_E0))
#define EB ((bf16_t*)(ws + WS_E))
#define U ((bf16_t*)OUTP)

    PH(0) { PH_IDS
        LAS float* scr = (LAS float*)(lds + wave * 16384);
        for (int it = gw; it < IT_IN + IT_GU; it += ngw) {
            int r = it;
            if (r < IT_IN) { const int kb = r / 304, nb = r % 304, n0 = 32 * nb; int dr = n0;
                if (n0 < 1280) { const int pn = n0 >> 8, c = n0 & 255, head = c >> 6, hf = (c & 63) >> 5; dr = pn * 256 + 128 * hf + head * 32; }
                transpose_item(INF(I_WIN), INW, WIN, 2048, dr, 64 * kb, 64 * kb, n0, scr, lane); continue; } r -= IT_IN;
            { const int kb = r / 352, nb = r % 352, n0 = 32 * nb; const int up = n0 >= DFF, j = up ? n0 - DFF : n0; const int dr = (j >> 7) * 256 + 128 * up + (j & 127);
                transpose_item(INF(I_WGU), NGU, WGU, 2048, dr, 64 * kb, 64 * kb, n0, scr, lane); }
        }
        for (int m = gw; m < T; m += ngw) rms_row_to_bf16(INF(I_X) + (size_t)m * DM, INF(I_GMIXPRE), HB + (size_t)m * DM, lane);
        const int gt = bid * 512 + tid, ngt = G * 512;
        const int* pos = (const int*)INF(I_POS);
        for (int i = gt; i < T * 32; i += ngt) { const int t = i >> 5, d = i & 31;
            const float invf = powf(10000.0f, -(float)d * (1.0f / 32.0f)); const float ang = (float)pos[t] * invf;
            const double rev = (double)ang * 0.15915494309189535; const float fr = (float)(rev - rint(rev));
            ROPE[(size_t)t * 64 + d] = __builtin_amdgcn_cosf(fr); ROPE[(size_t)t * 64 + 32 + d] = __builtin_amdgcn_sinf(fr); }
        for (int i = gt; i < 1024; i += ngt) { const float l0 = INF(I_LBL)[i], l1 = INF(I_LBL)[1024 + i]; LB[i] = 1.0f / (1.0f + expf(l1 - l0)); }
    }
    GSYNC;
    if (G > (1 << 20)) grid.sync();

    PH(1) {
        pg8::Gemm g{HB, WIN, 2048, 32}; pg8::StaticOrder S; S.init(T, INW, G, bid);
        pg8::EpiProj E{ws, lds};
        pg8::gemm_phase(lds, g, S, E, MYTID);
        const int rem = ((T / 256) * (INW / 256)) % G;
        if (rem == 0 || bid >= rem) { PH_IDS (void)gw;
            LAS float* scr = (LAS float*)(lds + wave * 16384);
            const int first = (rem == 0 ? bid : bid - rem) * 8 + wave, step = (rem == 0 ? G : G - rem) * 8;
            {
                const int gt2 = (rem == 0 ? bid : bid - rem) * 512 + tid, ngt2 = (rem == 0 ? G : G - rem) * 512;
                for (int i = gt2; i < T * 64; i += ngt2) { const f32x4 v = ((const f32x4*)INF(I_P))[i]; u32x2 w; w.x = pk2(v[0], v[1]); w.y = pk2(v[2], v[3]); ((u32x2*)PB)[i] = w; }
            }
            for (int it = first; it < IT_REST; it += step) {
                int r = it;
                if (r < IT_DN) { const int kb = r / 64, nb = r % 64; transpose_item(INF(I_WDN), DM, WDN, DFF, 32 * nb, 64 * kb, 64 * kb, 32 * nb, scr, lane); continue; } r -= IT_DN;
                if (r < IT_SQ) { const int kb = r / 64, nb = r % 64; transpose_item(INF(I_WOUT), DM, WOUT, 2048, 32 * nb, 64 * kb, 64 * kb, 32 * nb, scr, lane); continue; } r -= IT_SQ;
                if (r < IT_SQ) { const int kb = r / 64, nb = r % 64; transpose_item(INF(I_WPG), DM, WPG, 2048, 32 * nb, 64 * kb, 64 * kb, 32 * nb, scr, lane); continue; } r -= IT_SQ;
                if (r < IT_BR) { const int kb = r / 64, nb = r % 64; transpose_item(INF(I_WATT), DM, WMRG, 2048, 32 * nb, 64 * kb, 64 * kb, 32 * nb, scr, lane); continue; } r -= IT_BR;
                if (r < IT_BR) { const int kb = r / 64, nb = r % 64; transpose_item(INF(I_WHGRN), DM, WMRG, 2048, 32 * nb, 1024 + 64 * kb, 64 * kb, 32 * nb, scr, lane); continue; } r -= IT_BR;
                { const int kb = r / 64, nb = r % 64; transpose_item(INF(I_WPP), DM, WPP, 256, 32 * nb, 64 * kb, 64 * kb, 32 * nb, scr, lane); }
            }
        }
    }
    GSYNC;

    PH(2) {
        { PH_IDS (void)wave; attn_units(lds, Qb, Kb, VT, INF(I_SINKS), HB, bid, G, tid); }
        { PH_IDS (void)wave; hgrn_passA_units(lds, HZ, HVT, LB, U, DC, bid, G, tid); }
    }
    GSYNC;

    PH(3) { PH_IDS
        const int gt = bid * 512 + tid, ngt = G * 512;
        for (int item = gt; item < 16 * 128 * 64; item += ngt) {
            const int kp = item & 63, dv = (item >> 6) & 127, bh = item >> 13;
            f32x2 s = {0.f, 0.f};
            const unsigned* up = (const unsigned*)(U + (size_t)bh * 128 * 16384 + (size_t)dv * 128) + kp;
            const f32x2* dp = (const f32x2*)(DC + (size_t)bh * 128 * 128) + kp;
            unsigned* sp = (unsigned*)(STb + (size_t)bh * 128 * 16384 + (size_t)dv * 128) + kp;
#pragma unroll 8
            for (int c = 0; c < 128; ++c) {
                sp[(size_t)c * 8192] = pk2(s[0], s[1]);
                const unsigned ub = up[(size_t)c * 8192]; const f32x2 u = {bflo(ub), bfhi(ub)}, d = dp[(size_t)c * 64];
                s = d * s + u;
            }
        }
    }
    GSYNC;

    PH(4) { PH_IDS
        bf16_t* YC = HB;
        for (int it = bid; it < 2048; it += G) { const int h = it & 7, c = (it >> 3) & 127, b = it >> 10;
            hgrn_passC(lds, HQ, HZ, HVT, HG, LB, STb, INF(I_GNORM), YC, b, c, h, tid); }
    }
    GSYNC;

    PH(5) {
        pg8::Gemm g{HB, WMRG, 2048, 16}; pg8::SplitKOrder S; S.b.init(T, DM, G, bid); S.kbytes = 1024 * 2;
        pg8::EpiMerged E{GSA, GSB, MRG};
        pg8::gemm_phase(lds, g, S, E, MYTID);
    }
    GSYNC;

    PH(6) {
        pg8::Gemm g{MRG, WOUT, 2048, 32}; pg8::StaticOrder S; S.init(T, DM, G, bid);
        pg8::EpiRowSSb E{Y1, PART};
        pg8::gemm_phase(lds, g, S, E, MYTID);
    }
    GSYNC;

    PH(7) { PH_IDS rowpass<false, true>(Y1, PART, INF(I_X), OUTP, INF(I_GMIXPOST), INF(I_GFFNPRE), HB, gw, ngw, lane); }
    GSYNC;

    PH(8) {
        pg8::Gemm g{HB, WGU, 2048, 32}; pg8::StaticOrder S; S.init(T, NGU, G, bid);
        pg8::EpiSwiglu E{ACT};
        pg8::gemm_phase(lds, g, S, E, MYTID);
    }
    GSYNC;

    PH(9) {
        pg8::Gemm g{ACT, WDN, DFF, DFF / 64}; pg8::StaticOrder S; S.init(T, DM, G, bid);
        pg8::EpiRowSSb E{Y2, PART};
        pg8::gemm_phase(lds, g, S, E, MYTID);
    }
    GSYNC;

    PH(10) { PH_IDS rowpass<true, true>(Y2, PART, OUTP, (void*)(ws + WS_X2), INF(I_GFFNPOST), INF(I_GPLEPRE), HB, gw, ngw, lane); }
    GSYNC;

    PH(11) {
        pg8::Gemm g{PB, WPP, 256, 4}; pg8::StaticOrder S; S.init(T, DM, G, bid);
        pg8::EpiE0 E{E0};
        pg8::gemm_phase(lds, g, S, E, MYTID);
    }
    __builtin_amdgcn_sched_barrier(0);
    PH(12) {
        pg8::Gemm g{HB, WPG, 2048, 32}; pg8::StaticOrder S; S.init(T, DM, G, bid);
        pg8::EpiPle E{E0, EB, PART};
        pg8::gemm_phase(lds, g, S, E, MYTID);
    }
    GSYNC;

    PH(13) { PH_IDS rowpass<true, false>(EB, PART, (const void*)(ws + WS_X2), OUTP, INF(I_GPLEPOST), nullptr, nullptr, gw, ngw, lane); }
}

extern "C" void kernel_launch(void* const* d_in, const int* in_sizes, int n_in, void* d_out, int out_size, void* d_ws, size_t ws_size, hipStream_t stream) {
    static int grid = 0;
    if (grid == 0) {
        if (n_in != 20 || out_size != T * DM || ws_size < WS_END) { fprintf(stderr, "kernel_launch: unexpected shapes (n_in %d out %d ws %zu)\n", n_in, out_size, ws_size); grid = -1; return; }
        int dev = 0, cus = 0, per_cu = 0;
        hipGetDevice(&dev); hipDeviceGetAttribute(&cus, hipDeviceAttributeMultiprocessorCount, dev);
        if (hipFuncSetAttribute((const void*)fwd_megakernel, hipFuncAttributeMaxDynamicSharedMemorySize, LDS_BYTES) != hipSuccess) { fprintf(stderr, "kernel_launch: hipFuncSetAttribute failed\n"); grid = -1; return; }
        if (hipOccupancyMaxActiveBlocksPerMultiprocessor(&per_cu, (const void*)fwd_megakernel, 512, LDS_BYTES) != hipSuccess || per_cu < 1) { fprintf(stderr, "kernel_launch: occupancy query gave %d\n", per_cu); per_cu = 1; }
        (void)hipGetLastError();
        grid = cus * 1;
        fprintf(stderr, "kernel_launch: grid %d (cus %d, per_cu %d)\n", grid, cus, per_cu);
    }
    if (grid < 0) return;
    if (hipMemsetAsync(d_ws, 0, 16384, stream) != hipSuccess) { fprintf(stderr, "kernel_launch: memset failed\n"); return; }
    Args a{};
    for (int i = 0; i < 20; ++i) a.in[i] = (const float*)d_in[i];
    a.out = (float*)d_out; a.ws = (unsigned char*)d_ws;
    void* args[] = {&a};
    hipError_t e = hipLaunchCooperativeKernel((const void*)fwd_megakernel, dim3(grid), dim3(512), args, LDS_BYTES, stream);
    if (e != hipSuccess) fprintf(stderr, "kernel_launch: cooperative launch failed: %s\n", hipGetErrorString(e));
}
```

```cpp
#include <hip/hip_runtime.h>
#include <hip/hip_cooperative_groups.h>
#include <cstdio>
#include <cstdint>
namespace cg = cooperative_groups;

#define LAS __attribute__((address_space(3)))
typedef unsigned short bf16_t;
typedef short bf16x8 __attribute__((ext_vector_type(8)));
typedef short bf16x4 __attribute__((ext_vector_type(4)));
typedef float f32x4 __attribute__((ext_vector_type(4)));
typedef float f32x2 __attribute__((ext_vector_type(2)));
typedef unsigned u32x4 __attribute__((ext_vector_type(4)));
typedef unsigned u32x2 __attribute__((ext_vector_type(2)));

constexpr int T = 16384, SEQ = 8192, DM = 2048, INW = 9728, DFF = 5632, NGU = 11264;
constexpr float RMS_EPS = 1e-6f;
constexpr size_t MiB = 1u << 20;
constexpr size_t WS_LB = 65536;
constexpr size_t WS_WMRG = 1 * MiB, WS_WOUT = 9 * MiB, WS_WGU = 17 * MiB, WS_WDN = 61 * MiB, WS_WPG = 83 * MiB, WS_WPP = 91 * MiB;
constexpr size_t WS_HB = 92 * MiB;
constexpr size_t WS_PB = 156 * MiB;
constexpr size_t WS_ROPE = 164 * MiB;
constexpr size_t WS_DC = 164 * MiB;
constexpr size_t WS_PART = 166 * MiB;
constexpr size_t WS_BIG = 168 * MiB;
constexpr size_t WS_WIN = WS_BIG, WS_Q = 206 * MiB, WS_K = 238 * MiB, WS_VT = 246 * MiB, WS_HQ = 254 * MiB, WS_HZ = 286 * MiB, WS_HVT = 318 * MiB,
                 WS_HG = 350 * MiB, WS_GSA = 382 * MiB, WS_GSB = 446 * MiB, WS_END = 510 * MiB;
constexpr size_t WS_ST = WS_BIG;
constexpr size_t WS_MRG = WS_HQ;
constexpr size_t WS_ACT = 334 * MiB;
constexpr size_t WS_Y1 = WS_BIG;
constexpr size_t WS_Y2 = WS_BIG;
constexpr size_t WS_E0 = 334 * MiB;
constexpr size_t WS_E = WS_BIG;
constexpr size_t WS_X2 = 398 * MiB;
constexpr int LDS_BYTES = 147456;

typedef float f32x2_t_ __attribute__((ext_vector_type(2)));
typedef __bf16 bf16x2_t_ __attribute__((ext_vector_type(2)));
__device__ __forceinline__ unsigned cvtpk_(float lo, float hi) { const f32x2_t_ v = {lo, hi}; const bf16x2_t_ b = __builtin_convertvector(v, bf16x2_t_); return __builtin_bit_cast(unsigned, b); }
__device__ __forceinline__ unsigned f2bf(float f) { return cvtpk_(f, f) & 0xffffu; }
__device__ __forceinline__ float bf2f(unsigned h) { return __builtin_bit_cast(float, h << 16); }
__device__ __forceinline__ unsigned pk2(float lo, float hi) { return cvtpk_(lo, hi); }
__device__ __forceinline__ unsigned f2bf_sw(float f) { unsigned u = __builtin_bit_cast(unsigned, f); return (u + 0x7fffu + ((u >> 16) & 1u)) >> 16; }
__device__ __forceinline__ unsigned pk2_sw(float lo, float hi) { return f2bf_sw(lo) | (f2bf_sw(hi) << 16); }
__device__ __forceinline__ float bflo(unsigned w) { return __builtin_bit_cast(float, w << 16); }
__device__ __forceinline__ float bfhi(unsigned w) { return __builtin_bit_cast(float, w & 0xffff0000u); }
__device__ __forceinline__ float wave_sum(float v) {
#pragma unroll
    for (int o = 1; o < 64; o <<= 1) v += __shfl_xor(v, o);
    return v;
}
__device__ __forceinline__ float sigmoidf_(float x) { return __builtin_amdgcn_rcpf(1.0f + __expf(-x)); }
__device__ __forceinline__ f32x4 mfma16(bf16x8 a, bf16x8 b, f32x4 c) { return __builtin_amdgcn_mfma_f32_16x16x32_bf16(a, b, c, 0, 0, 0); }

namespace pg8 {
constexpr int BM = 256, BK = 64, HALF = 128, HTB = HALF * BK * 2, NXCD = 8, WGM = 8;
__host__ __device__ __forceinline__ int lds_byte(int r, int c) { const int st = (r >> 4) * 2 + (c >> 5), rr = r & 15, cc = c & 31, ob = rr * 64 + cc * 2; return st * 1024 + (ob ^ (((ob >> 9) & 1) << 5)); }
__host__ __device__ __forceinline__ void stage_rc(int b, int& R, int& C) { const int st = b / 1024, sb = b % 1024, swz = sb ^ (((sb >> 9) & 1) << 5); R = (st >> 1) * 16 + swz / 64; C = (st & 1) * 32 + (swz % 64) / 2; }
__host__ __device__ __forceinline__ int perm32(int rho) { const int n = rho >> 4, i = rho & 15; return 8 * (i >> 2) + 4 * n + (i & 3); }

struct Unit { int pm, pn, koff, half; };
struct Gemm { const bf16_t* A; const bf16_t* Bt; int ld; int nt; };

struct StaticOrder {
    int nM, nN, nwg, G, c;
    __device__ void init(int M, int N, int G_, int c_) { nM = M / BM; nN = N / BM; nwg = nM * nN; G = G_; c = c_; }
    __device__ bool next(int i, Unit& u) const {
        const long L = (long)i * G + c; if (L >= nwg) return false;
        int wgid = (int)L; { const int q = nwg / NXCD, r = nwg % NXCD, xcd = wgid % NXCD, off = wgid / NXCD; wgid = (xcd < r ? xcd * (q + 1) : r * (q + 1) + (xcd - r) * q) + off; }
        const int nig = WGM * nN, gid = wgid / nig, fm = gid * WGM, gsz = (nM - fm) < WGM ? (nM - fm) : WGM;
        u.pm = fm + ((wgid % nig) % gsz); u.pn = (wgid % nig) / gsz; u.koff = 0; u.half = 0; return true;
    }
};
struct SplitKOrder {
    StaticOrder b; int kbytes;
    __device__ bool next(int i, Unit& u) const { if (!b.next(i >> 1, u)) return false; u.half = i & 1; u.koff = (i & 1) * kbytes; return true; }
};

__device__ __forceinline__ unsigned cvt_pk_bf16(float lo, float hi) { unsigned r; asm volatile("v_cvt_pk_bf16_f32 %0, %1, %2" : "=v"(r) : "v"(lo), "v"(hi)); return r; }
typedef __amdgpu_buffer_rsrc_t rsrc_t;
__device__ __forceinline__ void st16w(rsrc_t rs, size_t off, u32x4 v) { __builtin_amdgcn_raw_buffer_store_b128(v, rs, (unsigned)off, 0, 16); }
__device__ __forceinline__ u32x4 pack8(f32x4 a, f32x4 b) { u32x4 w; w.x = cvt_pk_bf16(a[0], a[1]); w.y = cvt_pk_bf16(a[2], a[3]); w.z = cvt_pk_bf16(b[0], b[1]); w.w = cvt_pk_bf16(b[2], b[3]); return w; }

template <class Epi, class Sched>
__device__ __forceinline__ void gemm_phase(LAS unsigned char* lds, const Gemm g, const Sched& S, const Epi& E, int tid_in) {
    int tid_ = tid_in; asm volatile("" : "+v"(tid_));
    const int tid = tid_, wid = __builtin_amdgcn_readfirstlane(tid >> 6), lane = tid & 63, wr = wid >> 2, wc = wid & 3, fr = lane & 15, fq = lane >> 4;
    const int K = g.ld, nt = g.nt;
    unsigned voffA[2], voffB[2];
#pragma unroll
    for (int i = 0; i < 2; ++i) { int R, C; stage_rc(tid * 16 + i * 8192, R, C); const int Rb = (R & ~31) + perm32(R & 31);
        voffA[i] = (unsigned)(R * K + C) * 2u; voffB[i] = (unsigned)(Rb * K + C) * 2u; }
    const size_t kstep = (size_t)(BK * 2);
    const size_t hstep = (size_t)HALF * K * 2;
    const size_t tstep = 2 * hstep;
    const unsigned ldsw = (unsigned)wid * 1024u;
    const int aoff = lds_byte(wr * 64 + fr, fq * 8), boff = lds_byte(wc * 32 + fr, fq * 8);
#define PG8_SA(b, h) (((b) * 2 + (h)) * HTB)
#define PG8_SB(b, h) ((4 + (b) * 2 + (h)) * HTB)
#define PG8_STAGE(bufoff, gbase, voff) do { _Pragma("unroll") for (int _i = 0; _i < 2; ++_i) \
        __builtin_amdgcn_global_load_lds((const unsigned*)((const char*)(gbase) + (voff)[_i]), (LAS unsigned*)(lds + (bufoff) + ldsw + _i * 8192), 16, 0, 0); } while (0)
#define PG8_LDA(dst, b, h) do { _Pragma("unroll") for (int m = 0; m < 4; ++m) _Pragma("unroll") for (int k = 0; k < 2; ++k) dst[m][k] = *(const LAS bf16x8*)(lds + PG8_SA(b, h) + aoff + m * 2048 + k * 1024); } while (0)
#define PG8_LDB(dst, b, h) do { _Pragma("unroll") for (int n = 0; n < 2; ++n) _Pragma("unroll") for (int k = 0; k < 2; ++k) dst[n][k] = *(const LAS bf16x8*)(lds + PG8_SB(b, h) + boff + n * 2048 + k * 1024); } while (0)
#define PG8_MMA(ai, bj, At, Bt) do { __builtin_amdgcn_s_setprio(1); _Pragma("unroll") for (int m = 0; m < 4; ++m) _Pragma("unroll") for (int n = 0; n < 2; ++n) _Pragma("unroll") for (int k = 0; k < 2; ++k) \
        acc[ai][bj][m][n] = __builtin_amdgcn_mfma_f32_16x16x32_bf16(Bt[n][k], At[m][k], acc[ai][bj][m][n], 0, 0, 0); __builtin_amdgcn_s_setprio(0); } while (0)
#define PG8_WAIT_V(n) asm volatile("s_waitcnt vmcnt(" #n ")" ::: "memory")
#define PG8_WAIT_L(n) asm volatile("s_waitcnt lgkmcnt(" #n ")" ::: "memory")
#define PG8_BAR __builtin_amdgcn_s_barrier()
#define PG8_SCHED __builtin_amdgcn_sched_barrier(0)
    Unit cur, nxt; int ui = 0;
    if (!S.next(0, cur)) return;
    f32x4 acc[2][2][4][2];
#pragma unroll
    for (int a = 0; a < 2; ++a)
#pragma unroll
        for (int b = 0; b < 2; ++b)
#pragma unroll
            for (int m = 0; m < 4; ++m)
#pragma unroll
                for (int n = 0; n < 2; ++n) acc[a][b][m][n] = (f32x4){0.f, 0.f, 0.f, 0.f};
    bf16x8 At[4][2], B0[2][2], B1[2][2];
    const char* cA = (const char*)g.A + (size_t)cur.pm * tstep + cur.koff; const char* cB = (const char*)g.Bt + (size_t)cur.pn * tstep + cur.koff;
    PG8_STAGE(PG8_SB(0, 0), cB, voffB); PG8_STAGE(PG8_SB(0, 1), cB + hstep, voffB); PG8_STAGE(PG8_SA(0, 0), cA, voffA); PG8_STAGE(PG8_SA(0, 1), cA + hstep, voffA);
    if (wr == 1) PG8_BAR;
    PG8_WAIT_V(2); PG8_BAR;
    PG8_STAGE(PG8_SB(1, 0), cB + kstep, voffB); PG8_STAGE(PG8_SB(1, 1), cB + hstep + kstep, voffB);
    PG8_WAIT_V(4); PG8_BAR;
    for (;;) {
        const bool has_next = S.next(ui + 1, nxt);
        const char* nA = has_next ? (const char*)g.A + (size_t)nxt.pm * tstep + nxt.koff : cA; const char* nB = has_next ? (const char*)g.Bt + (size_t)nxt.pn * tstep + nxt.koff : cB;
        for (int t = 0; t < nt; t += 2) {
            const bool last = (t == nt - 2);
            const char* a1 = cA + (size_t)(t + 1) * kstep;
            const char* a2 = last ? nA : cA + (size_t)(t + 2) * kstep; const char* b2 = last ? nB : cB + (size_t)(t + 2) * kstep;
            const char* a3 = a2 + kstep; const char* b3 = b2 + kstep;
            PG8_LDB(B0, 0, 0); PG8_LDB(B1, 0, 1); PG8_SCHED; PG8_LDA(At, 0, 0); PG8_STAGE(PG8_SA(1, 0), a1, voffA); PG8_STAGE(PG8_SA(1, 1), a1 + hstep, voffA);
            PG8_WAIT_V(8); PG8_WAIT_L(0); PG8_BAR; PG8_MMA(0, 0, At, B0); PG8_MMA(0, 1, At, B1); PG8_BAR; PG8_SCHED;
            PG8_LDA(At, 0, 1); PG8_STAGE(PG8_SB(0, 0), b2, voffB); PG8_STAGE(PG8_SB(0, 1), b2 + hstep, voffB);
            PG8_WAIT_V(6); PG8_WAIT_L(0); PG8_BAR; PG8_MMA(1, 0, At, B0); PG8_MMA(1, 1, At, B1); PG8_BAR; PG8_SCHED;
            PG8_LDB(B0, 1, 0); PG8_LDB(B1, 1, 1); PG8_SCHED; PG8_LDA(At, 1, 0); PG8_STAGE(PG8_SA(0, 0), a2, voffA); PG8_STAGE(PG8_SA(0, 1), a2 + hstep, voffA);
            PG8_WAIT_V(8); PG8_WAIT_L(0); PG8_BAR; PG8_MMA(0, 0, At, B0); PG8_MMA(0, 1, At, B1); PG8_BAR; PG8_SCHED;
            PG8_LDA(At, 1, 1); PG8_STAGE(PG8_SB(1, 0), b3, voffB); PG8_STAGE(PG8_SB(1, 1), b3 + hstep, voffB);
            PG8_WAIT_V(6); PG8_WAIT_L(0); PG8_BAR; PG8_MMA(1, 0, At, B0); PG8_MMA(1, 1, At, B1); PG8_BAR; PG8_SCHED;
        }
        if (wr == 0) PG8_BAR;
        const bool keep = E(acc, cur, wr, wc, fr, fq);
        if (!has_next) break;
        if (!keep) {
#pragma unroll
            for (int a = 0; a < 2; ++a)
#pragma unroll
                for (int b = 0; b < 2; ++b)
#pragma unroll
                    for (int m = 0; m < 4; ++m)
#pragma unroll
                        for (int n = 0; n < 2; ++n) acc[a][b][m][n] = (f32x4){0.f, 0.f, 0.f, 0.f};
        }
        cur = nxt; cA = nA; cB = nB; ++ui;
        if (wr == 1) PG8_BAR;
    }
    PG8_WAIT_V(0);
    PG8_BAR;
#undef PG8_SA
#undef PG8_SB
#undef PG8_STAGE
#undef PG8_LDA
#undef PG8_LDB
#undef PG8_MMA
#undef PG8_WAIT_V
#undef PG8_WAIT_L
#undef PG8_BAR
#undef PG8_SCHED
}

struct EpiProj {
    unsigned char* ws; rsrc_t rs;
    __device__ __forceinline__ bool operator()(f32x4 (&acc)[2][2][4][2], const Unit& u, int wr, int wc, int fr, int fq) const {
        const int pn = u.pn; const int row0 = u.pm * BM + wr * 64 + fr;
        if (pn < 5) {
            const float* rope = (const float*)(ws + WS_ROPE);
            const bool isq = pn < 4;
            const size_t obase = isq ? WS_Q : WS_K; const int ldo = isq ? 1024 : 256, hcol = isq ? (pn * 4 + wc) * 64 : wc * 64; const float sc = isq ? 0.125f : 1.0f;
#pragma unroll
            for (int ai = 0; ai < 2; ++ai) {
                f32x4 tb[4][4];
#pragma unroll
                for (int m = 0; m < 4; ++m) { const f32x4* rp = (const f32x4*)(rope + (size_t)(row0 + ai * HALF + m * 16) * 64 + 8 * fq); tb[m][0] = rp[0]; tb[m][1] = rp[1]; tb[m][2] = rp[8]; tb[m][3] = rp[9]; }
#pragma unroll
                for (int m = 0; m < 4; ++m) {
                    const int row = row0 + ai * HALF + m * 16;
                    const f32x4 c0 = tb[m][0], c1 = tb[m][1], s0 = tb[m][2], s1 = tb[m][3];
                    const f32x4 x1a = acc[ai][0][m][0], x1b = acc[ai][0][m][1], x2a = acc[ai][1][m][0], x2b = acc[ai][1][m][1];
                    const f32x4 o1a = (x1a * c0 - x2a * s0) * sc, o1b = (x1b * c1 - x2b * s1) * sc;
                    const f32x4 o2a = (x2a * c0 + x1a * s0) * sc, o2b = (x2b * c1 + x1b * s1) * sc;
                    const size_t oo = obase + ((size_t)row * ldo + hcol + 8 * fq) * 2;
                    st16w(rs, oo, pack8(o1a, o1b)); st16w(rs, oo + 64, pack8(o2a, o2b));
                }
            }
        } else if (pn == 5 || (pn >= 14 && pn < 18)) {
            bf16_t* O = (bf16_t*)(ws + ((pn == 5) ? WS_VT : WS_HVT + (size_t)(pn - 14) * 256 * T * 2));
#pragma unroll
            for (int bj = 0; bj < 2; ++bj)
#pragma unroll
                for (int n = 0; n < 2; ++n)
#pragma unroll
                    for (int i = 0; i < 4; ++i) {
                        const int col = bj * HALF + wc * 32 + 8 * fq + 4 * n + i;
                        bf16_t* op = O + (size_t)col * T + row0;
#pragma unroll
                        for (int ai = 0; ai < 2; ++ai)
#pragma unroll
                            for (int m = 0; m < 4; ++m) op[ai * HALF + m * 16] = (bf16_t)f2bf(acc[ai][bj][m][n][i]);
                    }
        } else {
            size_t ooff; int ldo, cb; int mode;
            if (pn < 10) { ooff = WS_HQ; ldo = 1024; cb = (pn - 6) * 256; mode = 3; }
            else if (pn < 14) { ooff = WS_HZ; ldo = 1024; cb = (pn - 10) * 256; mode = 0; }
            else if (pn < 22) { ooff = WS_HG; ldo = 1024; cb = (pn - 18) * 256; mode = 2; }
            else if (pn < 30) { ooff = WS_GSA; ldo = 2048; cb = (pn - 22) * 256; mode = 1; }
            else { ooff = WS_GSB; ldo = 2048; cb = (pn - 30) * 256; mode = 1; }

            const float osc = (mode == 3) ? 0.08838834764831845f : 1.0f;
#pragma unroll
            for (int ai = 0; ai < 2; ++ai)
#pragma unroll
                for (int m = 0; m < 4; ++m) {
                    const size_t rowo = ooff + ((size_t)(row0 + ai * HALF + m * 16) * ldo + cb + wc * 32 + 8 * fq) * 2;
#pragma unroll
                    for (int bj = 0; bj < 2; ++bj) {
                        f32x4 v[2] = {acc[ai][bj][m][0], acc[ai][bj][m][1]};
#pragma unroll
                        for (int n = 0; n < 2; ++n)
#pragma unroll
                            for (int i = 0; i < 4; ++i) { const float x = v[n][i]; const float s = sigmoidf_(x); v[n][i] = (mode == 0) ? x : (mode == 1) ? s : x * s * osc; }
                        st16w(rs, rowo + bj * HALF * 2, pack8(v[0], v[1]));
                    }
                }
        }
        return false;
    }
};
struct EpiMerged {
    const bf16_t *GSA, *GSB; rsrc_t rs;
    __device__ __forceinline__ bool operator()(f32x4 (&acc)[2][2][4][2], const Unit& u, int wr, int wc, int fr, int fq) const {
        const int row0 = u.pm * BM + wr * 64 + fr, col0 = u.pn * BM + wc * 32 + 8 * fq;
#pragma unroll
        for (int ai = 0; ai < 2; ++ai) {
            u32x4 gb[4][2], ga[4][2];
#pragma unroll
            for (int m = 0; m < 4; ++m)
#pragma unroll
                for (int bj = 0; bj < 2; ++bj) {
                    const size_t off = (size_t)(row0 + ai * HALF + m * 16) * DM + col0 + bj * HALF;
                    gb[m][bj] = *(const u32x4*)(GSB + off);
                    if (u.half == 0) ga[m][bj] = *(const u32x4*)(GSA + off);
                }
#pragma unroll
            for (int m = 0; m < 4; ++m)
#pragma unroll
                for (int bj = 0; bj < 2; ++bj) {
                    const size_t off = (size_t)(row0 + ai * HALF + m * 16) * DM + col0 + bj * HALF;
                    const u32x4 sb = gb[m][bj];
                    const float fb[8] = {bflo(sb.x), bfhi(sb.x), bflo(sb.y), bfhi(sb.y), bflo(sb.z), bfhi(sb.z), bflo(sb.w), bfhi(sb.w)};
                    if (u.half == 0) {
                        const u32x4 sa = ga[m][bj];
                        const float fa[8] = {bflo(sa.x), bfhi(sa.x), bflo(sa.y), bfhi(sa.y), bflo(sa.z), bfhi(sa.z), bflo(sa.w), bfhi(sa.w)};
#pragma unroll
                        for (int n = 0; n < 2; ++n)
#pragma unroll
                            for (int i = 0; i < 4; ++i) acc[ai][bj][m][n][i] *= fa[4 * n + i] * __builtin_amdgcn_rcpf(fb[4 * n + i]);
                    } else {
                        f32x4 v0, v1;
#pragma unroll
                        for (int i = 0; i < 4; ++i) { v0[i] = acc[ai][bj][m][0][i] * fb[i]; v1[i] = acc[ai][bj][m][1][i] * fb[4 + i]; }
                        st16w(rs, WS_MRG + off * 2, pack8(v0, v1));
                    }
                }
        }
        return u.half == 0;
    }
};
struct EpiRowSS {
    float* Y; float* part;
    __device__ __forceinline__ bool operator()(f32x4 (&acc)[2][2][4][2], const Unit& u, int wr, int wc, int fr, int fq) const {
        const int row0 = u.pm * BM + wr * 64 + fr, col0 = u.pn * BM + wc * 32 + 8 * fq;
#pragma unroll
        for (int ai = 0; ai < 2; ++ai)
#pragma unroll
            for (int m = 0; m < 4; ++m) {
                const int row = row0 + ai * HALF + m * 16; float ss = 0.f;
#pragma unroll
                for (int bj = 0; bj < 2; ++bj) {
                    const f32x4 v0 = acc[ai][bj][m][0], v1 = acc[ai][bj][m][1];
                    float* yp = Y + (size_t)row * DM + col0 + bj * HALF;
                    *(f32x4*)yp = v0; *(f32x4*)(yp + 4) = v1;
                    ss += (v0[0] * v0[0] + v0[1] * v0[1]) + (v0[2] * v0[2] + v0[3] * v0[3]) + (v1[0] * v1[0] + v1[1] * v1[1]) + (v1[2] * v1[2] + v1[3] * v1[3]);
                }
                ss += __shfl_xor(ss, 16); ss += __shfl_xor(ss, 32);
                if (fq == 0) part[(size_t)row * 32 + u.pn * 4 + wc] = ss;
            }
        return false;
    }
};
struct EpiRowSSb {
    size_t ybase; float* part; rsrc_t rs;
    __device__ __forceinline__ bool operator()(f32x4 (&acc)[2][2][4][2], const Unit& u, int wr, int wc, int fr, int fq) const {
        const int row0 = u.pm * BM + wr * 64 + fr, col0 = u.pn * BM + wc * 32 + 8 * fq;
#pragma unroll
        for (int ai = 0; ai < 2; ++ai)
#pragma unroll
            for (int m = 0; m < 4; ++m) {
                const int row = row0 + ai * HALF + m * 16; float ss = 0.f;
#pragma unroll
                for (int bj = 0; bj < 2; ++bj) {
                    const f32x4 v0 = acc[ai][bj][m][0], v1 = acc[ai][bj][m][1];
                    st16w(rs, ybase + ((size_t)row * DM + col0 + bj * HALF) * 2, pack8(v0, v1));
                    ss += (v0[0] * v0[0] + v0[1] * v0[1]) + (v0[2] * v0[2] + v0[3] * v0[3]) + (v1[0] * v1[0] + v1[1] * v1[1]) + (v1[2] * v1[2] + v1[3] * v1[3]);
                }
                ss += __shfl_xor(ss, 16); ss += __shfl_xor(ss, 32);
                if (fq == 0) part[(size_t)row * 32 + u.pn * 4 + wc] = ss;
            }
        return false;
    }
};
struct EpiSwiglu {
    rsrc_t rs;
    __device__ __forceinline__ bool operator()(f32x4 (&acc)[2][2][4][2], const Unit& u, int wr, int wc, int fr, int fq) const {
        const int row0 = u.pm * BM + wr * 64 + fr, col0 = u.pn * HALF + wc * 32 + 8 * fq;
#pragma unroll
        for (int ai = 0; ai < 2; ++ai)
#pragma unroll
            for (int m = 0; m < 4; ++m) {
                f32x4 v[2];
#pragma unroll
                for (int n = 0; n < 2; ++n)
#pragma unroll
                    for (int i = 0; i < 4; ++i) { const float gx = acc[ai][0][m][n][i]; v[n][i] = gx * sigmoidf_(gx) * acc[ai][1][m][n][i]; }
                st16w(rs, WS_ACT + ((size_t)(row0 + ai * HALF + m * 16) * DFF + col0) * 2, pack8(v[0], v[1]));
            }
        return false;
    }
};
struct EpiE0 {
    rsrc_t rs;
    __device__ __forceinline__ bool operator()(f32x4 (&acc)[2][2][4][2], const Unit& u, int wr, int wc, int fr, int fq) const {
        const int row0 = u.pm * BM + wr * 64 + fr, col0 = u.pn * BM + wc * 32 + 8 * fq;
#pragma unroll
        for (int ai = 0; ai < 2; ++ai)
#pragma unroll
            for (int m = 0; m < 4; ++m)
#pragma unroll
                for (int bj = 0; bj < 2; ++bj)
                    st16w(rs, WS_E0 + ((size_t)(row0 + ai * HALF + m * 16) * DM + col0 + bj * HALF) * 2, pack8(acc[ai][bj][m][0], acc[ai][bj][m][1]));
        return false;
    }
};
struct EpiPle {
    const bf16_t* E0; rsrc_t rs; float* part;
    __device__ __forceinline__ bool operator()(f32x4 (&acc)[2][2][4][2], const Unit& u, int wr, int wc, int fr, int fq) const {
        const int row0 = u.pm * BM + wr * 64 + fr, col0 = u.pn * BM + wc * 32 + 8 * fq;
#pragma unroll
        for (int ai = 0; ai < 2; ++ai)
#pragma unroll
            for (int m = 0; m < 4; ++m) {
                const int row = row0 + ai * HALF + m * 16; float ss = 0.f;
#pragma unroll
                for (int bj = 0; bj < 2; ++bj) {
                    const size_t off = (size_t)row * DM + col0 + bj * HALF;
                    const u32x4 eb = *(const u32x4*)(E0 + off);
                    const float fe[8] = {bflo(eb.x), bfhi(eb.x), bflo(eb.y), bfhi(eb.y), bflo(eb.z), bfhi(eb.z), bflo(eb.w), bfhi(eb.w)};
                    f32x4 v[2];
#pragma unroll
                    for (int n = 0; n < 2; ++n)
#pragma unroll
                        for (int i = 0; i < 4; ++i) { const float e = fe[4 * n + i] * sigmoidf_(acc[ai][bj][m][n][i]); v[n][i] = e; ss += e * e; }
                    st16w(rs, WS_E + off * 2, pack8(v[0], v[1]));
                }
                ss += __shfl_xor(ss, 16); ss += __shfl_xor(ss, 32);
                if (fq == 0) part[(size_t)row * 32 + u.pn * 4 + wc] = ss;
            }
        return false;
    }
};
}

__device__ __forceinline__ void transpose_item(const float* W, int N, bf16_t* WT, int dst_ld, int dst_row0, int dst_k0, int k0, int n0, LAS float* scr, int lane) {
#pragma unroll 8
    for (int i = 0; i < 32; ++i) { const int kk = 2 * i + (lane >> 5); scr[kk * 33 + (lane & 31)] = W[(size_t)(k0 + kk) * N + n0 + (lane & 31)]; }
    asm volatile("s_waitcnt lgkmcnt(0)" ::: "memory");
    const int c = lane & 7;
#pragma unroll
    for (int j = 0; j < 4; ++j) { const int n = (lane >> 3) + 8 * j; const LAS float* s = scr + (8 * c) * 33 + n;
        u32x4 o; o.x = pk2(s[0 * 33], s[1 * 33]); o.y = pk2(s[2 * 33], s[3 * 33]); o.z = pk2(s[4 * 33], s[5 * 33]); o.w = pk2(s[6 * 33], s[7 * 33]);
        *(u32x4*)(WT + (size_t)(dst_row0 + n) * dst_ld + dst_k0 + 8 * c) = o; }
    asm volatile("s_waitcnt lgkmcnt(0)" ::: "memory");
}
__device__ __forceinline__ void rms_row_to_bf16(const float* xrow, const float* gain, bf16_t* orow, int lane) {
    const f32x4* xr = (const f32x4*)xrow + lane; const f32x4* gr = (const f32x4*)gain + lane;
    f32x4 v[8]; float s = 0.f;
#pragma unroll
    for (int j = 0; j < 8; ++j) { v[j] = xr[64 * j]; s += (v[j][0] * v[j][0] + v[j][1] * v[j][1]) + (v[j][2] * v[j][2] + v[j][3] * v[j][3]); }
    const float rstd = rsqrtf(wave_sum(s) * (1.0f / DM) + RMS_EPS);
    u32x2* o8 = (u32x2*)orow + lane;
#pragma unroll
    for (int j = 0; j < 8; ++j) { const f32x4 g = gr[64 * j]; u32x2 w; w.x = pk2(v[j][0] * rstd * g[0], v[j][1] * rstd * g[1]); w.y = pk2(v[j][2] * rstd * g[2], v[j][3] * rstd * g[3]); o8[64 * j] = w; }
}
template <bool XIB, bool XOB> __device__ __forceinline__ void rowpass(const bf16_t* Y, const float* part, const void* Xin, void* Xout, const float* g_post, const float* g_pre, bf16_t* Hout, int gw, int ngw, int lane_) {
    int lane = lane_; asm volatile("" : "+v"(lane));
    f32x4 gp[8];
#pragma unroll
    for (int j = 0; j < 8; ++j) gp[j] = ((const f32x4*)g_post)[lane + 64 * j];
    u32x2 ny[8]; f32x4 nxf[8]; u32x2 nxb[8]; float np = 0.f;
#define RP_LOAD(r) do { np = part[(size_t)(r) * 32 + (lane & 31)]; \
        const u32x2* yb_ = (const u32x2*)(Y + (size_t)(r) * DM) + lane; \
        _Pragma("unroll") for (int j = 0; j < 8; ++j) { ny[j] = yb_[64 * j]; \
            if (XIB) nxb[j] = ((const u32x2*)((const bf16_t*)Xin + (size_t)(r) * DM) + lane)[64 * j]; else nxf[j] = ((const f32x4*)((const float*)Xin + (size_t)(r) * DM) + lane)[64 * j]; } } while (0)
    int row = gw;
    if (row < T) RP_LOAD(row);
    for (; row < T; row += ngw) {
        u32x2 cy[8]; f32x4 cx[8]; float p = np;
#pragma unroll
        for (int j = 0; j < 8; ++j) { cy[j] = ny[j]; if (XIB) cx[j] = (f32x4){bflo(nxb[j].x), bfhi(nxb[j].x), bflo(nxb[j].y), bfhi(nxb[j].y)}; else cx[j] = nxf[j]; }
        if (row + ngw < T) RP_LOAD(row + ngw);
#pragma unroll
        for (int o = 1; o < 32; o <<= 1) p += __shfl_xor(p, o);
        const float rstd = rsqrtf(p * (1.0f / DM) + RMS_EPS);
        f32x4* of = (f32x4*)((float*)Xout + (size_t)row * DM) + lane; u32x2* ob = (u32x2*)((bf16_t*)Xout + (size_t)row * DM) + lane;
        f32x4 v[8]; float s = 0.f;
#pragma unroll
        for (int j = 0; j < 8; ++j) {
            const f32x4 y = {bflo(cy[j].x), bfhi(cy[j].x), bflo(cy[j].y), bfhi(cy[j].y)};
            v[j] = cx[j] + y * rstd * gp[j];
            if (XOB) { u32x2 o2; o2.x = pk2(v[j][0], v[j][1]); o2.y = pk2(v[j][2], v[j][3]); ob[64 * j] = o2; } else of[64 * j] = v[j];
            s += (v[j][0] * v[j][0] + v[j][1] * v[j][1]) + (v[j][2] * v[j][2] + v[j][3] * v[j][3]);
        }
        if (Hout) {
            const float r2 = rsqrtf(wave_sum(s) * (1.0f / DM) + RMS_EPS);
            const f32x4* gq = (const f32x4*)g_pre + lane; u32x2* o8 = (u32x2*)(Hout + (size_t)row * DM) + lane;
#pragma unroll
            for (int j = 0; j < 8; ++j) { const f32x4 g = gq[64 * j]; u32x2 w; w.x = pk2(v[j][0] * r2 * g[0], v[j][1] * r2 * g[1]); w.y = pk2(v[j][2] * r2 * g[2], v[j][3] * r2 * g[3]); o8[64 * j] = w; }
        }
    }
#undef RP_LOAD
}

#define LDS_BAR do { asm volatile("s_waitcnt lgkmcnt(0)" ::: "memory"); __builtin_amdgcn_s_barrier(); asm volatile("" ::: "memory"); } while (0)
__device__ __forceinline__ void attn_units(LAS unsigned char* lds, const bf16_t* Q, const bf16_t* Kk, const bf16_t* VT, const float* sinks, bf16_t* Y, int bid, int G, int tid) {
    const int lane = tid & 63, wave = tid >> 6, g = lane >> 4, n = lane & 15;
    LAS bf16_t* KL = (LAS bf16_t*)lds;
    LAS bf16_t* VL = (LAS bf16_t*)(lds + 36864);
    for (int it = bid; it < 512; it += G) {
        const int kvh = it & 3, blk = (it >> 2) & 63, b = it >> 8, s0 = blk * 128 + wave * 16, ks = blk * 128 - 128; const size_t tokb = (size_t)b * SEQ;
        u32x4 kst[4], vst[4];
#pragma unroll
        for (int ps = 0; ps < 4; ++ps) { const int row = ps * 64 + (tid >> 3), kr = ks + row; kst[ps] = *(const u32x4*)(Kk + (tokb + (kr < 0 ? 0 : kr)) * 256 + kvh * 64 + 8 * (tid & 7)); }
#pragma unroll
        for (int ps = 0; ps < 4; ++ps) { const int row = ps * 16 + (tid >> 5), kc = ks + 8 * (tid & 31); vst[ps] = *(const u32x4*)(VT + (size_t)(kvh * 64 + row) * T + tokb + (kc < 0 ? 0 : kc)); }
        const bf16_t* qp = Q + (tokb + s0 + n) * 1024 + (kvh * 4) * 64 + 8 * g;
        bf16x8 qf[2];
        qf[0] = *(const bf16x8*)qp; qf[1] = *(const bf16x8*)(qp + 32);
#pragma unroll
        for (int ps = 0; ps < 4; ++ps) *(LAS u32x4*)(KL + (ps * 64 + (tid >> 3)) * 72 + 8 * (tid & 7)) = kst[ps];
#pragma unroll
        for (int ps = 0; ps < 4; ++ps) *(LAS u32x4*)(VL + (ps * 16 + (tid >> 5)) * 264 + 8 * (tid & 31)) = vst[ps];
        __syncthreads();
        bf16x8 kf[9][2];
#pragma unroll
        for (int j = 0; j < 9; ++j) { const LAS bf16_t* kp = KL + (16 * wave + 16 * j + n) * 72 + 8 * g; kf[j][0] = *(const LAS bf16x8*)kp; kf[j][1] = *(const LAS bf16x8*)(kp + 32); }
        bf16x8 pf[4][5]; float inv[4];
#pragma unroll
        for (int hh = 0; hh < 4; ++hh) {
            f32x4 sc[9];
#pragma unroll
            for (int j = 0; j < 9; ++j) { f32x4 a = {0.f, 0.f, 0.f, 0.f}; a = mfma16(kf[j][0], qf[0], a); a = mfma16(kf[j][1], qf[1], a); sc[j] = a; }
            if (hh < 3) { qf[0] = *(const bf16x8*)(qp + (hh + 1) * 64); qf[1] = *(const bf16x8*)(qp + (hh + 1) * 64 + 32); }
            const float sink = sinks[kvh * 4 + hh];
            float mx = sink;
#pragma unroll
            for (int j = 0; j < 9; ++j) {
                const int key0 = s0 - 128 + 16 * j;
#pragma unroll
                for (int i = 0; i < 4; ++i) {
                    const int kr = 4 * g + i;
                    bool valid = key0 >= 0;
                    if (j == 0) valid = valid && (kr >= n + 1);
                    if (j == 8) valid = valid && (kr <= n);
                    const float v = valid ? sc[j][i] : -1e30f;
                    sc[j][i] = v; mx = fmaxf(mx, v);
                }
            }
            mx = fmaxf(mx, __shfl_xor(mx, 16)); mx = fmaxf(mx, __shfl_xor(mx, 32));
            float l = 0.f;
#pragma unroll
            for (int j = 0; j < 9; ++j)
#pragma unroll
                for (int i = 0; i < 4; ++i) { const float p = __expf(sc[j][i] - mx); sc[j][i] = p; l += p; }
            l += __shfl_xor(l, 16); l += __shfl_xor(l, 32);
            l += __expf(sink - mx);
            inv[hh] = 1.0f / l;
#pragma unroll
            for (int ks5 = 0; ks5 < 5; ++ks5) {
                const f32x4 pa = sc[2 * ks5]; const f32x4 pb = (2 * ks5 + 1 < 9) ? sc[(2 * ks5 + 1 < 9) ? 2 * ks5 + 1 : 0] : (f32x4){0.f, 0.f, 0.f, 0.f};
                u32x4 w; w.x = pk2_sw(pa[0], pa[1]); w.y = pk2_sw(pa[2], pa[3]); w.z = pk2_sw(pb[0], pb[1]); w.w = pk2_sw(pb[2], pb[3]);
                pf[hh][ks5] = __builtin_bit_cast(bf16x8, w);
            }
        }
#pragma unroll
        for (int dt = 0; dt < 4; ++dt) {
            const LAS bf16_t* vrow = VL + (dt * 16 + n) * 264 + 16 * wave + 4 * g;
            bf16x8 vf[5];
#pragma unroll
            for (int ks5 = 0; ks5 < 5; ++ks5) {
                const u32x2 va = *(const LAS u32x2*)(vrow + 32 * ks5);
                u32x2 vb = {0u, 0u}; if (ks5 < 4) vb = *(const LAS u32x2*)(vrow + 32 * ks5 + 16);
                u32x4 w; w.x = va.x; w.y = va.y; w.z = vb.x; w.w = vb.y; vf[ks5] = __builtin_bit_cast(bf16x8, w);
            }
#pragma unroll
            for (int hh = 0; hh < 4; ++hh) {
                f32x4 acc = {0.f, 0.f, 0.f, 0.f};
#pragma unroll
                for (int ks5 = 0; ks5 < 5; ++ks5) acc = mfma16(vf[ks5], pf[hh][ks5], acc);
                u32x2 o; o.x = pk2_sw(acc[0] * inv[hh], acc[1] * inv[hh]); o.y = pk2_sw(acc[2] * inv[hh], acc[3] * inv[hh]);
                *(u32x2*)(Y + (tokb + s0 + n) * DM + (kvh * 4 + hh) * 64 + dt * 16 + 4 * g) = o;
            }
        }
        __syncthreads();
    }
}

__device__ __forceinline__ void hgrn_passA_units(LAS unsigned char* lds, const bf16_t* HZ, const bf16_t* HVT, const float* LB, bf16_t* U, float* DC, int bid, int G, int tid) {
    const int k = tid & 127, I = tid >> 7, lane = tid & 63, w = tid >> 6, g = lane >> 4, n = lane & 15;
    LAS float* TOT = (LAS float*)lds;
    LAS bf16_t* KT = (LAS bf16_t*)(lds + 2048);
    LAS bf16_t* VS = (LAS bf16_t*)(lds + 2048 + 18432);
#define PA_DECODE(r_) const int h = (r_) & 7, c = ((r_) >> 3) & 127, b = (r_) >> 10; const size_t tok0 = (size_t)b * SEQ + (size_t)c * 64; const int ch = (b * 8 + h) * 128 + c;
#define PA_LOADZ(r_) do { PA_DECODE(r_) (void)ch; _Pragma("unroll") for (int i = 0; i < 16; ++i) zn[i] = HZ[(tok0 + 16 * I + i) * 1024 + h * 128 + k]; } while (0)
    unsigned short zn[16];
    int r = bid;
    if (r >= 2048) return;
    PA_LOADZ(r);
    for (; r < 2048; r += G) {
        PA_DECODE(r)
        const float lb = LB[h * 128 + k], oml = 1.0f - lb;
        unsigned short zc[16];
#pragma unroll
        for (int i = 0; i < 16; ++i) zc[i] = zn[i];
        u32x4 vst[2];
#pragma unroll
        for (int ps = 0; ps < 2; ++ps) vst[ps] = *(const u32x4*)(HVT + (size_t)(h * 128 + 64 * ps + (tid >> 3)) * T + tok0 + 8 * (tid & 7));
        if (r + G < 2048) PA_LOADZ(r + G);
        float cs[16], kk[16]; float run = 0.f;
#pragma unroll
        for (int i = 0; i < 16; ++i) {
            const float z = bf2f(zc[i]);
            const float e = __expf(-z), s = __builtin_amdgcn_rcpf(1.0f + e);
            run += __logf(lb + oml * s); cs[i] = run; kk[i] = oml * e * s;
        }
        TOT[I * 128 + k] = run;
        LDS_BAR;
        const float t0 = TOT[k], t1 = TOT[128 + k], t2 = TOT[256 + k], t3 = TOT[384 + k];
        const float rI = (I > 0 ? t0 : 0.f) + (I > 1 ? t1 : 0.f) + (I > 2 ? t2 : 0.f);
        const float blast = (t0 + t1) + (t2 + t3);
        unsigned pw[8];
#pragma unroll
        for (int i = 0; i < 8; ++i) pw[i] = pk2(kk[2 * i] * __expf(blast - rI - cs[2 * i]), kk[2 * i + 1] * __expf(blast - rI - cs[2 * i + 1]));
        LAS u32x4* kd = (LAS u32x4*)(KT + k * 72 + 16 * I);
        kd[0] = (u32x4){pw[0], pw[1], pw[2], pw[3]}; kd[1] = (u32x4){pw[4], pw[5], pw[6], pw[7]};
        if (I == 0) DC[(size_t)ch * 128 + k] = __expf(blast);
#pragma unroll
        for (int ps = 0; ps < 2; ++ps) *(LAS u32x4*)(VS + (64 * ps + (tid >> 3)) * 72 + 8 * (tid & 7)) = vst[ps];
        LDS_BAR;
        f32x4 acc[8];
#pragma unroll
        for (int d = 0; d < 8; ++d) acc[d] = (f32x4){0.f, 0.f, 0.f, 0.f};
#pragma unroll
        for (int st = 0; st < 2; ++st) {
            const bf16x8 a = *(const LAS bf16x8*)(KT + (16 * w + n) * 72 + 32 * st + 8 * g);
#pragma unroll
            for (int d = 0; d < 8; ++d) acc[d] = mfma16(a, *(const LAS bf16x8*)(VS + (16 * d + n) * 72 + 32 * st + 8 * g), acc[d]);
        }
#pragma unroll
        for (int d = 0; d < 8; ++d) { u32x2 o; o.x = pk2(acc[d][0], acc[d][1]); o.y = pk2(acc[d][2], acc[d][3]); *(u32x2*)(U + (size_t)ch * 16384 + (size_t)(16 * d + n) * 128 + 16 * w + 4 * g) = o; }
        LDS_BAR;
    }
#undef PA_DECODE
#undef PA_LOADZ
}

__device__ __forceinline__ void hgrn_passC(LAS unsigned char* lds, const bf16_t* HQ, const bf16_t* HZ, const bf16_t* HVT, const bf16_t* HG, const float* LB, const bf16_t* ST,
                                           const float* gnorm, bf16_t* Y, int b, int c, int h, int tid) {
    const int kp = tid & 63, sb = tid >> 6, I = sb >> 1, hf = sb & 1, lane = tid & 63, w = tid >> 6, g = lane >> 4, n = lane & 15;
    const size_t tok0 = (size_t)b * SEQ + (size_t)c * 64; const int ch = (b * 8 + h) * 128 + c;
    LAS float* TOT = (LAS float*)lds;
    LAS float* SS = (LAS float*)(lds + 4096);
    LAS bf16_t* QE = (LAS bf16_t*)(lds + 4608);
    LAS bf16_t* QI = QE + 64 * 136;
    LAS bf16_t* KB = QI + 64 * 136;
    LAS bf16_t* STS = (LAS bf16_t*)(lds + 82944);
    LAS bf16_t* VS = (LAS bf16_t*)(lds + 117760);
    const f32x2 lb2 = *(const f32x2*)(LB + h * 128 + 2 * kp);
    const int Iw = w & 3, dvh = w >> 2;
    unsigned zr[8], qr[8];
#pragma unroll
    for (int i = 0; i < 8; ++i) { zr[i] = *(const unsigned*)(HZ + (tok0 + 8 * sb + i) * 1024 + h * 128 + 2 * kp); qr[i] = *(const unsigned*)(HQ + (tok0 + 8 * sb + i) * 1024 + h * 128 + 2 * kp); }
    u32x4 sts[4], vst[2]; u32x2 hgv[4];
#pragma unroll
    for (int ps = 0; ps < 4; ++ps) sts[ps] = *(const u32x4*)(ST + (size_t)ch * 16384 + (size_t)(32 * ps + (tid >> 4)) * 128 + 8 * (tid & 15));
#pragma unroll
    for (int ps = 0; ps < 2; ++ps) vst[ps] = *(const u32x4*)(HVT + (size_t)(h * 128 + 64 * ps + (tid >> 3)) * T + tok0 + 8 * (tid & 7));
#pragma unroll
    for (int d4 = 0; d4 < 4; ++d4) hgv[d4] = *(const u32x2*)(HG + (tok0 + 16 * Iw + n) * 1024 + h * 128 + 16 * (4 * dvh + d4) + 4 * g);
    float cs[2][8], kk[2][8]; float run[2] = {0.f, 0.f};
#pragma unroll
    for (int i = 0; i < 8; ++i)
#pragma unroll
        for (int cc = 0; cc < 2; ++cc) {
            const float z = cc ? bfhi(zr[i]) : bflo(zr[i]); const float lb = lb2[cc], oml = 1.0f - lb;
            const float e = __expf(-z), s_ = __builtin_amdgcn_rcpf(1.0f + e);
            run[cc] += __logf(lb + oml * s_); cs[cc][i] = run[cc]; kk[cc][i] = oml * e * s_;
        }
    *(LAS f32x2*)(TOT + sb * 128 + 2 * kp) = (f32x2){run[0], run[1]};
    __syncthreads();
    f32x2 tt[7];
#pragma unroll
    for (int j = 0; j < 7; ++j) tt[j] = *(const LAS f32x2*)(TOT + j * 128 + 2 * kp);
    float eI[2], fI[2][4], pre[2];
#pragma unroll
    for (int cc = 0; cc < 2; ++cc) {
        const float r1 = tt[0][cc] + tt[1][cc], r2 = r1 + tt[2][cc] + tt[3][cc], r3 = r2 + tt[4][cc] + tt[5][cc];
        const float rI = (I == 0) ? 0.f : (I == 1) ? r1 : (I == 2) ? r2 : r3;
        const float tfirst = (I == 0) ? tt[0][cc] : (I == 1) ? tt[2][cc] : (I == 2) ? tt[4][cc] : tt[6][cc];
        pre[cc] = hf ? tfirst : 0.f;
        eI[cc] = __expf(rI);
        fI[cc][0] = __expf(0.f - rI); fI[cc][1] = __expf(r1 - rI); fI[cc][2] = __expf(r2 - rI); fI[cc][3] = __expf(r3 - rI);
    }
#pragma unroll
    for (int i = 0; i < 8; ++i) {
        const int t = 8 * sb + i, rowb = 8 * hf + i;
        float qi[2], kinv[2];
#pragma unroll
        for (int cc = 0; cc < 2; ++cc) { const float ecs = __expf(pre[cc] + cs[cc][i]); qi[cc] = (cc ? bfhi(qr[i]) : bflo(qr[i])) * ecs; kinv[cc] = kk[cc][i] * __builtin_amdgcn_rcpf(ecs); }
        *(LAS unsigned*)(QE + t * 136 + 2 * kp) = cvtpk_(qi[0] * eI[0], qi[1] * eI[1]);
        *(LAS unsigned*)(QI + t * 136 + 2 * kp) = cvtpk_(qi[0], qi[1]);
#pragma unroll
        for (int Ip = 0; Ip < 4; ++Ip) {
            if (Ip >= I) {
                const int blk = Ip * (Ip + 1) / 2 + I;
                *(LAS unsigned*)(KB + (blk * 16 + rowb) * 136 + 2 * kp) = cvtpk_(kinv[0] * fI[0][Ip], kinv[1] * fI[1][Ip]);
            }
        }
    }
#pragma unroll
    for (int ps = 0; ps < 4; ++ps) *(LAS u32x4*)(STS + (32 * ps + (tid >> 4)) * 136 + 8 * (tid & 15)) = sts[ps];
#pragma unroll
    for (int ps = 0; ps < 2; ++ps) *(LAS u32x4*)(VS + (64 * ps + (tid >> 3)) * 72 + 8 * (tid & 7)) = vst[ps];
    __syncthreads();
    f32x4 at[4];
#pragma unroll
    for (int J = 0; J < 4; ++J) {
        f32x4 a4 = {0.f, 0.f, 0.f, 0.f};
        if (J <= Iw) {
            const int blk = Iw * (Iw + 1) / 2 + J;
#pragma unroll
            for (int st = 0; st < 4; ++st) {
                const bf16x8 a = *(const LAS bf16x8*)(KB + (blk * 16 + n) * 136 + 32 * st + 8 * g);
                const bf16x8 bq = *(const LAS bf16x8*)(QI + (16 * Iw + n) * 136 + 32 * st + 8 * g);
                a4 = mfma16(a, bq, a4);
            }
            if (J == Iw) {
#pragma unroll
                for (int i = 0; i < 4; ++i) if (4 * g + i > n) a4[i] = 0.f;
            }
        }
        at[J] = a4;
    }
    bf16x8 pf[2];
#pragma unroll
    for (int ks = 0; ks < 2; ++ks) { u32x4 wv; wv.x = pk2(at[2 * ks][0], at[2 * ks][1]); wv.y = pk2(at[2 * ks][2], at[2 * ks][3]); wv.z = pk2(at[2 * ks + 1][0], at[2 * ks + 1][1]); wv.w = pk2(at[2 * ks + 1][2], at[2 * ks + 1][3]);
        pf[ks] = __builtin_bit_cast(bf16x8, wv); }
    f32x4 o[4]; float ss = 0.f;
#pragma unroll
    for (int d4 = 0; d4 < 4; ++d4) {
        f32x4 acc = {0.f, 0.f, 0.f, 0.f};
#pragma unroll
        for (int st = 0; st < 4; ++st) {
            const bf16x8 bq = *(const LAS bf16x8*)(QE + (16 * Iw + n) * 136 + 32 * st + 8 * g);
            acc = mfma16(*(const LAS bf16x8*)(STS + (16 * (4 * dvh + d4) + n) * 136 + 32 * st + 8 * g), bq, acc);
        }
        const LAS bf16_t* vl = VS + (16 * (4 * dvh + d4) + n) * 72 + 4 * g;
        { const u32x2 v0 = *(const LAS u32x2*)vl, v1 = *(const LAS u32x2*)(vl + 16); u32x4 wv; wv.x = v0.x; wv.y = v0.y; wv.z = v1.x; wv.w = v1.y; acc = mfma16(__builtin_bit_cast(bf16x8, wv), pf[0], acc); }
        { const u32x2 v0 = *(const LAS u32x2*)(vl + 32), v1 = *(const LAS u32x2*)(vl + 48); u32x4 wv; wv.x = v0.x; wv.y = v0.y; wv.z = v1.x; wv.w = v1.y; acc = mfma16(__builtin_bit_cast(bf16x8, wv), pf[1], acc); }
        o[d4] = acc; ss += (acc[0] * acc[0] + acc[1] * acc[1]) + (acc[2] * acc[2] + acc[3] * acc[3]);
    }
    ss += __shfl_xor(ss, 16); ss += __shfl_xor(ss, 32);
    if (g == 0) SS[dvh * 64 + 16 * Iw + n] = ss;
    __syncthreads();
    const float tot = SS[16 * Iw + n] + SS[64 + 16 * Iw + n];
    const float rstd = rsqrtf(tot * (1.0f / 128.0f) + RMS_EPS);
#pragma unroll
    for (int d4 = 0; d4 < 4; ++d4) {
        const int dv = 16 * (4 * dvh + d4) + 4 * g;
        const f32x4 gn = *(const f32x4*)(gnorm + dv);
        const u32x2 hg = hgv[d4];
        u32x2 ov; ov.x = pk2(o[d4][0] * rstd * gn[0] * bflo(hg.x), o[d4][1] * rstd * gn[1] * bfhi(hg.x)); ov.y = pk2(o[d4][2] * rstd * gn[2] * bflo(hg.y), o[d4][3] * rstd * gn[3] * bfhi(hg.y));
        *(u32x2*)(Y + (tok0 + 16 * Iw + n) * DM + 1024 + h * 128 + dv) = ov;
    }
    __syncthreads();
}

#define XB_TMO      128
#define XB_XCNT(j)  (256  + 64 * (j))
#define XB_XSUB(j)  (1280 + 64 * (j))
#define XB_XGEN(j)  (2304 + 64 * (j))
#define XB_TOP      3328
#define XB_TOPGEN   3392
#define XCD_BAR_WORDS 3456
#define XB_SPIN_CAP (1u << 18)
__device__ __forceinline__ unsigned xb_ld(unsigned* p)              { return __hip_atomic_load(p, __ATOMIC_RELAXED, __HIP_MEMORY_SCOPE_AGENT); }
__device__ __forceinline__ unsigned xb_add(unsigned* p, unsigned v) { return __hip_atomic_fetch_add(p, v, __ATOMIC_RELAXED, __HIP_MEMORY_SCOPE_AGENT); }
__device__ __forceinline__ unsigned xb_xcc_id() { return (unsigned)__builtin_amdgcn_s_getreg((3 << 11) | 20) & 0xFu; }
#define XB_SPIN(cond, bar) do { unsigned _sp = 0; while (cond) { __builtin_amdgcn_s_sleep(1); \
    if ((++_sp & 255u) == 0u) { if (xb_ld(&(bar)[XB_TMO])) break; if (_sp > XB_SPIN_CAP) { atomicAdd(&(bar)[XB_TMO], 1u); break; } } } } while (0)
__device__ __forceinline__ void xcd_barrier_complete(unsigned* bar, unsigned x, unsigned& nloc, unsigned& nx) {
    const unsigned G = gridDim.x * gridDim.y * gridDim.z;
    unsigned sum, cnt, mine, sp = 0u;
    for (;;) {
        sum = 0u; cnt = 0u; mine = 0u;
#pragma unroll
        for (unsigned j = 0; j < 16; ++j) { const unsigned c = xb_ld(&bar[XB_XCNT(j)]); sum += c; cnt += (c > 0u) ? 1u : 0u; mine = (j == x) ? c : mine; }
        if (sum == G) break;
        __builtin_amdgcn_s_sleep(1);
        if ((++sp & 255u) == 0u) { if (xb_ld(&bar[XB_TMO])) break; if (sp > XB_SPIN_CAP) { atomicAdd(&bar[XB_TMO], 1u); break; } }
    }
    nloc = mine > 0u ? mine : 1u; nx = cnt > 0u ? cnt : 1u;
}
__device__ __forceinline__ void xcd_barrier(unsigned* bar, volatile LAS unsigned* st, bool tid0) {
    asm volatile("s_waitcnt vmcnt(0)" ::: "memory");
    __syncthreads();
    if (tid0) {
        const unsigned x = xb_xcc_id();
        __builtin_amdgcn_s_waitcnt(0);
        unsigned nloc = st[0], nx = st[1];
        if (nloc == 0u) { xcd_barrier_complete(bar, x, nloc, nx); st[0] = nloc; st[1] = nx; }
        const unsigned old = xb_add(&bar[XB_XSUB(x)], 1u);
        const unsigned gen = old / nloc;
        if (old + 1u == (gen + 1u) * nloc) {
            __builtin_amdgcn_fence(__ATOMIC_RELEASE, "agent");
            asm volatile("s_waitcnt vmcnt(0)" ::: "memory");
            const unsigned og = xb_add(&bar[XB_TOP], 1u);
            const unsigned tg = og / nx;
            if (og + 1u == (tg + 1u) * nx) xb_add(&bar[XB_TOPGEN], 1u);
            else XB_SPIN(xb_ld(&bar[XB_TOPGEN]) == tg, bar);
            __builtin_amdgcn_fence(__ATOMIC_ACQUIRE, "agent");
            xb_add(&bar[XB_XGEN(x)], 1u);
            asm volatile("s_waitcnt vmcnt(0)" ::: "memory");
        } else {
            XB_SPIN(xb_ld(&bar[XB_XGEN(x)]) == gen, bar);
            __builtin_amdgcn_fence(__ATOMIC_ACQUIRE, "agent");
            asm volatile("s_waitcnt vmcnt(0)" ::: "memory");
        }
    }
    __syncthreads();
}

__device__ __forceinline__ void counter_barrier(unsigned* cnt, unsigned target, bool tid0) {
    __builtin_amdgcn_fence(__ATOMIC_RELEASE, "agent");
    asm volatile("s_waitcnt vmcnt(0)" ::: "memory");
    __syncthreads();
    if (tid0) {
        __hip_atomic_fetch_add(cnt, 1u, __ATOMIC_RELAXED, __HIP_MEMORY_SCOPE_AGENT);
        while (__hip_atomic_load(cnt, __ATOMIC_RELAXED, __HIP_MEMORY_SCOPE_AGENT) < target) __builtin_amdgcn_s_sleep(2);
    }
    __syncthreads();
    __builtin_amdgcn_fence(__ATOMIC_ACQUIRE, "agent");
    asm volatile("s_waitcnt vmcnt(0)" ::: "memory");
}

#ifndef PHASE_MASK
#define PHASE_MASK 0xFFFFF
#endif
#ifndef REP_MASK
#define REP_MASK 0
#endif
#define PH(k) if constexpr ((PHASE_MASK >> (k)) & 1) _Pragma("nounroll") for (int rep_ = 0; rep_ < ((((REP_MASK) >> (k)) & 1) ? 2 : 1); ++rep_)
constexpr int IT_IN = 32 * 304, IT_GU = 32 * 352, IT_DN = 88 * 64, IT_SQ = 32 * 64, IT_BR = 16 * 64, IT_PP = 4 * 64;
constexpr int IT_REST = IT_DN + 2 * IT_SQ + 2 * IT_BR + IT_PP;
struct Args { const float* in[20]; float* out; unsigned char* ws; };
enum { I_X = 0, I_P, I_POS, I_GMIXPRE, I_WIN, I_SINKS, I_LBL, I_GNORM, I_WATT, I_WHGRN, I_WOUT, I_GMIXPOST, I_GFFNPRE, I_WGU, I_WDN, I_GFFNPOST, I_GPLEPRE, I_WPG, I_WPP, I_GPLEPOST };

__device__ __forceinline__ int my_lane_() { int l; asm volatile("v_mbcnt_lo_u32_b32 %0, -1, 0\n\tv_mbcnt_hi_u32_b32 %0, -1, %0" : "=v"(l)); return l; }
__device__ __forceinline__ void* ldptr(LAS unsigned long long* PT, int k) {
    const unsigned long long v = PT[k];
    const unsigned lo = __builtin_amdgcn_readfirstlane((unsigned)v), hi = __builtin_amdgcn_readfirstlane((unsigned)(v >> 32));
    return (void*)(__attribute__((address_space(1))) void*)(((unsigned long long)hi << 32) | lo);
}
__global__ void __launch_bounds__(512, 2) fwd_megakernel(Args a) {
    extern __shared__ __attribute__((aligned(16))) unsigned char lds_raw[];
    LAS unsigned char* lds = (LAS unsigned char*)lds_raw;
    cg::grid_group grid = cg::this_grid();
    const int G = gridDim.x, bid = blockIdx.x, ngw = G * 8;
    const int wave_s = __builtin_amdgcn_readfirstlane((int)threadIdx.x >> 6);
#define MYLANE my_lane_()
#define MYTID (wave_s * 64 + MYLANE)
#define PH_IDS int tid_l = MYTID; asm volatile("" : "+v"(tid_l)); const int tid = tid_l, lane = tid & 63, wave = __builtin_amdgcn_readfirstlane(tid >> 6), gw = bid * 8 + wave; (void)lane; (void)gw;
    LAS unsigned long long* PT = (LAS unsigned long long*)(lds + 146432 + 64);
    volatile LAS unsigned* XST = (volatile LAS unsigned*)(lds + 146432);
    if (threadIdx.x == 0) {
#pragma unroll
        for (int i = 0; i < 20; ++i) PT[i] = (unsigned long long)a.in[i];
        PT[20] = (unsigned long long)a.out; PT[21] = (unsigned long long)a.ws;
        XST[0] = 0u; XST[1] = 0u;
        (void)xb_add((unsigned*)a.ws + XB_XCNT(xb_xcc_id()), 1u);
    }
    __syncthreads();
#define GSYNC xcd_barrier((unsigned*)ws, XST, MYTID == 0)
#define LDP(k) ldptr(PT, (k))
#define INF(k) ((const float*)LDP(k))
#define OUTP ((float*)LDP(20))
    unsigned char* ws = (unsigned char*)LDP(21);
#define RS __builtin_amdgcn_make_buffer_rsrc(ws, 0, 0x7fffffff, 0x00020000)
#define WIN ((bf16_t*)(ws + WS_WIN))
#define WMRG ((bf16_t*)(ws + WS_WMRG))
#define WOUT ((bf16_t*)(ws + WS_WOUT))
#define WGU ((bf16_t*)(ws + WS_WGU))
#define WDN ((bf16_t*)(ws + WS_WDN))
#define WPG ((bf16_t*)(ws + WS_WPG))
#define WPP ((bf16_t*)(ws + WS_WPP))
#define HB ((bf16_t*)(ws + WS_HB))
#define PB ((bf16_t*)(ws + WS_PB))
#define ROPE ((float*)(ws + WS_ROPE))
#define LB ((float*)(ws + WS_LB))
#define DC ((float*)(ws + WS_DC))
#define PART ((float*)(ws + WS_PART))
#define Qb ((bf16_t*)(ws + WS_Q))
#define Kb ((bf16_t*)(ws + WS_K))
#define VT ((bf16_t*)(ws + WS_VT))
#define HQ ((bf16_t*)(ws + WS_HQ))
#define HZ ((bf16_t*)(ws + WS_HZ))
#define HVT ((bf16_t*)(ws + WS_HVT))
#define HG ((bf16_t*)(ws + WS_HG))
#define GSA ((bf16_t*)(ws + WS_GSA))
#define GSB ((bf16_t*)(ws + WS_GSB))
#define STb ((bf16_t*)(ws + WS_ST))
#define MRG ((bf16_t*)(ws + WS_MRG))
#define ACT ((bf16_t*)(ws + WS_ACT))
#define Y1 ((bf16_t*)(ws + WS_Y1))
#define Y2 ((bf16_t*)(ws + WS_Y2))
#define E0 ((bf16_t*)(ws + WS_E0))
#define EB ((bf16_t*)(ws + WS_E))
#define U ((bf16_t*)OUTP)

    PH(0) { PH_IDS
        LAS float* scr = (LAS float*)(lds + wave * 16384);
        for (int it = gw; it < IT_IN + IT_GU; it += ngw) {
            int r = it;
            if (r < IT_IN) { const int kb = r / 304, nb = r % 304, n0 = 32 * nb; int dr = n0;
                if (n0 < 1280) { const int pn = n0 >> 8, c = n0 & 255, head = c >> 6, hf = (c & 63) >> 5; dr = pn * 256 + 128 * hf + head * 32; }
                transpose_item(INF(I_WIN), INW, WIN, 2048, dr, 64 * kb, 64 * kb, n0, scr, lane); continue; } r -= IT_IN;
            { const int kb = r / 352, nb = r % 352, n0 = 32 * nb; const int up = n0 >= DFF, j = up ? n0 - DFF : n0; const int dr = (j >> 7) * 256 + 128 * up + (j & 127);
                transpose_item(INF(I_WGU), NGU, WGU, 2048, dr, 64 * kb, 64 * kb, n0, scr, lane); }
        }
        for (int m = gw; m < T; m += ngw) rms_row_to_bf16(INF(I_X) + (size_t)m * DM, INF(I_GMIXPRE), HB + (size_t)m * DM, lane);
        const int gt = bid * 512 + tid, ngt = G * 512;
        const int* pos = (const int*)INF(I_POS);
        for (int i = gt; i < T * 32; i += ngt) { const int t = i >> 5, d = i & 31;
            const float invf = powf(10000.0f, -(float)d * (1.0f / 32.0f)); const float ang = (float)pos[t] * invf;
            const double rev = (double)ang * 0.15915494309189535; const float fr = (float)(rev - rint(rev));
            ROPE[(size_t)t * 64 + d] = __builtin_amdgcn_cosf(fr); ROPE[(size_t)t * 64 + 32 + d] = __builtin_amdgcn_sinf(fr); }
        for (int i = gt; i < 1024; i += ngt) { const float l0 = INF(I_LBL)[i], l1 = INF(I_LBL)[1024 + i]; LB[i] = 1.0f / (1.0f + expf(l1 - l0)); }
    }
    GSYNC;
    if (G > (1 << 20)) grid.sync();

    PH(1) {
        pg8::Gemm g{HB, WIN, 2048, 32}; pg8::StaticOrder S; S.init(T, INW, G, bid);
        pg8::EpiProj E{ws, RS};
        pg8::gemm_phase(lds, g, S, E, MYTID);
        const int rem = ((T / 256) * (INW / 256)) % G;
        if (rem == 0 || bid >= rem) { PH_IDS (void)gw;
            LAS float* scr = (LAS float*)(lds + wave * 16384);
            const int first = (rem == 0 ? bid : bid - rem) * 8 + wave, step = (rem == 0 ? G : G - rem) * 8;
            {
                const int gt2 = (rem == 0 ? bid : bid - rem) * 512 + tid, ngt2 = (rem == 0 ? G : G - rem) * 512;
                for (int i = gt2; i < T * 64; i += ngt2) { const f32x4 v = ((const f32x4*)INF(I_P))[i]; u32x2 w; w.x = pk2(v[0], v[1]); w.y = pk2(v[2], v[3]); ((u32x2*)PB)[i] = w; }
            }
            for (int it = first; it < IT_REST; it += step) {
                int r = it;
                if (r < IT_DN) { const int kb = r / 64, nb = r % 64; transpose_item(INF(I_WDN), DM, WDN, DFF, 32 * nb, 64 * kb, 64 * kb, 32 * nb, scr, lane); continue; } r -= IT_DN;
                if (r < IT_SQ) { const int kb = r / 64, nb = r % 64; transpose_item(INF(I_WOUT), DM, WOUT, 2048, 32 * nb, 64 * kb, 64 * kb, 32 * nb, scr, lane); continue; } r -= IT_SQ;
                if (r < IT_SQ) { const int kb = r / 64, nb = r % 64; transpose_item(INF(I_WPG), DM, WPG, 2048, 32 * nb, 64 * kb, 64 * kb, 32 * nb, scr, lane); continue; } r -= IT_SQ;
                if (r < IT_BR) { const int kb = r / 64, nb = r % 64; transpose_item(INF(I_WATT), DM, WMRG, 2048, 32 * nb, 64 * kb, 64 * kb, 32 * nb, scr, lane); continue; } r -= IT_BR;
                if (r < IT_BR) { const int kb = r / 64, nb = r % 64; transpose_item(INF(I_WHGRN), DM, WMRG, 2048, 32 * nb, 1024 + 64 * kb, 64 * kb, 32 * nb, scr, lane); continue; } r -= IT_BR;
                { const int kb = r / 64, nb = r % 64; transpose_item(INF(I_WPP), DM, WPP, 256, 32 * nb, 64 * kb, 64 * kb, 32 * nb, scr, lane); }
            }
        }
    }
    GSYNC;

    PH(2) {
        { PH_IDS (void)wave; attn_units(lds, Qb, Kb, VT, INF(I_SINKS), HB, bid, G, tid); }
        { PH_IDS (void)wave; hgrn_passA_units(lds, HZ, HVT, LB, U, DC, bid, G, tid); }
    }
    GSYNC;

    PH(3) { PH_IDS
        const int gt = bid * 512 + tid, ngt = G * 512;
        for (int item = gt; item < 16 * 128 * 64; item += ngt) {
            const int kp = item & 63, dv = (item >> 6) & 127, bh = item >> 13;
            f32x2 s = {0.f, 0.f};
            const unsigned* up = (const unsigned*)(U + (size_t)bh * 128 * 16384 + (size_t)dv * 128) + kp;
            const f32x2* dp = (const f32x2*)(DC + (size_t)bh * 128 * 128) + kp;
            unsigned* sp = (unsigned*)(STb + (size_t)bh * 128 * 16384 + (size_t)dv * 128) + kp;
#pragma unroll 8
            for (int c = 0; c < 128; ++c) {
                sp[(size_t)c * 8192] = pk2(s[0], s[1]);
                const unsigned ub = up[(size_t)c * 8192]; const f32x2 u = {bflo(ub), bfhi(ub)}, d = dp[(size_t)c * 64];
                s = d * s + u;
            }
        }
    }
    GSYNC;

    PH(4) { PH_IDS
        bf16_t* YC = HB;
        for (int it = bid; it < 2048; it += G) { const int h = it & 7, c = (it >> 3) & 127, b = it >> 10;
            hgrn_passC(lds, HQ, HZ, HVT, HG, LB, STb, INF(I_GNORM), YC, b, c, h, tid); }
    }
    GSYNC;

    PH(5) {
        pg8::Gemm g{HB, WMRG, 2048, 16}; pg8::SplitKOrder S; S.b.init(T, DM, G, bid); S.kbytes = 1024 * 2;
        pg8::EpiMerged E{GSA, GSB, RS};
        pg8::gemm_phase(lds, g, S, E, MYTID);
    }
    GSYNC;

    PH(6) {
        pg8::Gemm g{MRG, WOUT, 2048, 32}; pg8::StaticOrder S; S.init(T, DM, G, bid);
        pg8::EpiRowSSb E{WS_Y1, PART, RS};
        pg8::gemm_phase(lds, g, S, E, MYTID);
    }
    GSYNC;

    PH(7) { PH_IDS rowpass<false, true>(Y1, PART, INF(I_X), OUTP, INF(I_GMIXPOST), INF(I_GFFNPRE), HB, gw, ngw, lane); }
    GSYNC;

    PH(8) {
        pg8::Gemm g{HB, WGU, 2048, 32}; pg8::StaticOrder S; S.init(T, NGU, G, bid);
        pg8::EpiSwiglu E{RS};
        pg8::gemm_phase(lds, g, S, E, MYTID);
    }
    GSYNC;

    PH(9) {
        pg8::Gemm g{ACT, WDN, DFF, DFF / 64}; pg8::StaticOrder S; S.init(T, DM, G, bid);
        pg8::EpiRowSSb E{WS_Y2, PART, RS};
        pg8::gemm_phase(lds, g, S, E, MYTID);
    }
    GSYNC;

    PH(10) { PH_IDS rowpass<true, true>(Y2, PART, OUTP, (void*)(ws + WS_X2), INF(I_GFFNPOST), INF(I_GPLEPRE), HB, gw, ngw, lane); }
    GSYNC;

    PH(11) {
        pg8::Gemm g{PB, WPP, 256, 4}; pg8::StaticOrder S; S.init(T, DM, G, bid);
        pg8::EpiE0 E{RS};
        pg8::gemm_phase(lds, g, S, E, MYTID);
    }
    __builtin_amdgcn_sched_barrier(0);
    PH(12) {
        pg8::Gemm g{HB, WPG, 2048, 32}; pg8::StaticOrder S; S.init(T, DM, G, bid);
        pg8::EpiPle E{E0, RS, PART};
        pg8::gemm_phase(lds, g, S, E, MYTID);
    }
    GSYNC;

    PH(13) { PH_IDS rowpass<true, false>(EB, PART, (const void*)(ws + WS_X2), OUTP, INF(I_GPLEPOST), nullptr, nullptr, gw, ngw, lane); }
}

extern "C" void kernel_launch(void* const* d_in, const int* in_sizes, int n_in, void* d_out, int out_size, void* d_ws, size_t ws_size, hipStream_t stream) {
    static int grid = 0;
    if (grid == 0) {
        if (n_in != 20 || out_size != T * DM || ws_size < WS_END) { fprintf(stderr, "kernel_launch: unexpected shapes (n_in %d out %d ws %zu)\n", n_in, out_size, ws_size); grid = -1; return; }
        int dev = 0, cus = 0, per_cu = 0;
        hipGetDevice(&dev); hipDeviceGetAttribute(&cus, hipDeviceAttributeMultiprocessorCount, dev);
        if (hipFuncSetAttribute((const void*)fwd_megakernel, hipFuncAttributeMaxDynamicSharedMemorySize, LDS_BYTES) != hipSuccess) { fprintf(stderr, "kernel_launch: hipFuncSetAttribute failed\n"); grid = -1; return; }
        if (hipOccupancyMaxActiveBlocksPerMultiprocessor(&per_cu, (const void*)fwd_megakernel, 512, LDS_BYTES) != hipSuccess || per_cu < 1) { fprintf(stderr, "kernel_launch: occupancy query gave %d\n", per_cu); per_cu = 1; }
        (void)hipGetLastError();
        grid = cus * 1;
        fprintf(stderr, "kernel_launch: grid %d (cus %d, per_cu %d)\n", grid, cus, per_cu);
    }
    if (grid < 0) return;
    if (hipMemsetAsync(d_ws, 0, 16384, stream) != hipSuccess) { fprintf(stderr, "kernel_launch: memset failed\n"); return; }
    Args a{};
    for (int i = 0; i < 20; ++i) a.in[i] = (const float*)d_in[i];
    a.out = (float*)d_out; a.ws = (unsigned char*)d_ws;
    void* args[] = {&a};
    hipError_t e = hipLaunchCooperativeKernel((const void*)fwd_megakernel, dim3(grid), dim3(512), args, LDS_BYTES, stream);
    if (e != hipSuccess) fprintf(stderr, "kernel_launch: cooperative launch failed: %s\n", hipGetErrorString(e));
}
```

```cpp
#include <hip/hip_runtime.h>
#include <hip/hip_cooperative_groups.h>
#include <cstdio>
#include <cstdint>
namespace cg = cooperative_groups;

#define LAS __attribute__((address_space(3)))
typedef unsigned short bf16_t;
typedef short bf16x8 __attribute__((ext_vector_type(8)));
typedef short bf16x4 __attribute__((ext_vector_type(4)));
typedef float f32x4 __attribute__((ext_vector_type(4)));
typedef float f32x2 __attribute__((ext_vector_type(2)));
typedef unsigned u32x4 __attribute__((ext_vector_type(4)));
typedef unsigned u32x2 __attribute__((ext_vector_type(2)));

constexpr int T = 16384, SEQ = 8192, DM = 2048, INW = 9728, DFF = 5632, NGU = 11264;
constexpr float RMS_EPS = 1e-6f;
constexpr size_t MiB = 1u << 20;
constexpr size_t WS_LB = 65536;
constexpr size_t WS_WMRG = 1 * MiB, WS_WOUT = 9 * MiB, WS_WGU = 17 * MiB, WS_WDN = 61 * MiB, WS_WPG = 83 * MiB, WS_WPP = 91 * MiB;
constexpr size_t WS_HB = 92 * MiB;
constexpr size_t WS_PB = 156 * MiB;
constexpr size_t WS_ROPE = 164 * MiB;
constexpr size_t WS_DC = 164 * MiB;
constexpr size_t WS_PART = 166 * MiB;
constexpr size_t WS_BIG = 168 * MiB;
constexpr size_t WS_WIN = WS_BIG, WS_Q = 206 * MiB, WS_K = 238 * MiB, WS_VT = 246 * MiB, WS_HQ = 254 * MiB, WS_HZ = 286 * MiB, WS_HVT = 318 * MiB,
                 WS_HG = 350 * MiB, WS_GSA = 382 * MiB, WS_GSB = 446 * MiB, WS_END = 510 * MiB;
constexpr size_t WS_ST = WS_BIG;
constexpr size_t WS_MRG = WS_HQ;
constexpr size_t WS_ACT = 334 * MiB;
constexpr size_t WS_Y1 = WS_BIG;
constexpr size_t WS_Y2 = WS_BIG;
constexpr size_t WS_E0 = 334 * MiB;
constexpr size_t WS_E = WS_BIG;
constexpr size_t WS_X2 = 398 * MiB;
constexpr int LDS_BYTES = 147456;

typedef float f32x2_t_ __attribute__((ext_vector_type(2)));
typedef __bf16 bf16x2_t_ __attribute__((ext_vector_type(2)));
__device__ __forceinline__ unsigned cvtpk_(float lo, float hi) { const f32x2_t_ v = {lo, hi}; const bf16x2_t_ b = __builtin_convertvector(v, bf16x2_t_); return __builtin_bit_cast(unsigned, b); }
__device__ __forceinline__ unsigned f2bf(float f) { return cvtpk_(f, f) & 0xffffu; }
__device__ __forceinline__ float bf2f(unsigned h) { return __builtin_bit_cast(float, h << 16); }
__device__ __forceinline__ unsigned pk2(float lo, float hi) { return cvtpk_(lo, hi); }
__device__ __forceinline__ unsigned f2bf_sw(float f) { unsigned u = __builtin_bit_cast(unsigned, f); return (u + 0x7fffu + ((u >> 16) & 1u)) >> 16; }
__device__ __forceinline__ unsigned pk2_sw(float lo, float hi) { return f2bf_sw(lo) | (f2bf_sw(hi) << 16); }
__device__ __forceinline__ float bflo(unsigned w) { return __builtin_bit_cast(float, w << 16); }
__device__ __forceinline__ float bfhi(unsigned w) { return __builtin_bit_cast(float, w & 0xffff0000u); }
__device__ __forceinline__ float wave_sum(float v) {
#pragma unroll
    for (int o = 1; o < 64; o <<= 1) v += __shfl_xor(v, o);
    return v;
}
__device__ __forceinline__ float sigmoidf_(float x) { return __builtin_amdgcn_rcpf(1.0f + __expf(-x)); }
__device__ __forceinline__ f32x4 mfma16(bf16x8 a, bf16x8 b, f32x4 c) { return __builtin_amdgcn_mfma_f32_16x16x32_bf16(a, b, c, 0, 0, 0); }

namespace pg8 {
constexpr int BM = 256, BK = 64, HALF = 128, HTB = HALF * BK * 2, NXCD = 8, WGM = 8;
__host__ __device__ __forceinline__ int lds_byte(int r, int c) { const int st = (r >> 4) * 2 + (c >> 5), rr = r & 15, cc = c & 31, ob = rr * 64 + cc * 2; return st * 1024 + (ob ^ (((ob >> 9) & 1) << 5)); }
__host__ __device__ __forceinline__ void stage_rc(int b, int& R, int& C) { const int st = b / 1024, sb = b % 1024, swz = sb ^ (((sb >> 9) & 1) << 5); R = (st >> 1) * 16 + swz / 64; C = (st & 1) * 32 + (swz % 64) / 2; }
__host__ __device__ __forceinline__ int perm32(int rho) { const int n = rho >> 4, i = rho & 15; return 8 * (i >> 2) + 4 * n + (i & 3); }

struct Unit { int pm, pn, koff, half; };
struct Gemm { const bf16_t* A; const bf16_t* Bt; int ld; int nt; };

struct StaticOrder {
    int nM, nN, nwg, G, c;
    __device__ void init(int M, int N, int G_, int c_) { nM = M / BM; nN = N / BM; nwg = nM * nN; G = G_; c = c_; }
    __device__ bool next(int i, Unit& u) const {
        const long L = (long)i * G + c; if (L >= nwg) return false;
        int wgid = (int)L; { const int q = nwg / NXCD, r = nwg % NXCD, xcd = wgid % NXCD, off = wgid / NXCD; wgid = (xcd < r ? xcd * (q + 1) : r * (q + 1) + (xcd - r) * q) + off; }
        const int nig = WGM * nN, gid = wgid / nig, fm = gid * WGM, gsz = (nM - fm) < WGM ? (nM - fm) : WGM;
        u.pm = fm + ((wgid % nig) % gsz); u.pn = (wgid % nig) / gsz; u.koff = 0; u.half = 0; return true;
    }
};
struct SplitKOrder {
    StaticOrder b; int kbytes;
    __device__ bool next(int i, Unit& u) const { if (!b.next(i >> 1, u)) return false; u.half = i & 1; u.koff = (i & 1) * kbytes; return true; }
};

__device__ __forceinline__ unsigned cvt_pk_bf16(float lo, float hi) { unsigned r; asm volatile("v_cvt_pk_bf16_f32 %0, %1, %2" : "=v"(r) : "v"(lo), "v"(hi)); return r; }
__device__ __forceinline__ u32x4 pack8(f32x4 a, f32x4 b) { u32x4 w; w.x = cvt_pk_bf16(a[0], a[1]); w.y = cvt_pk_bf16(a[2], a[3]); w.z = cvt_pk_bf16(b[0], b[1]); w.w = cvt_pk_bf16(b[2], b[3]); return w; }

template <class Epi, class Sched>
__device__ __forceinline__ void gemm_phase(LAS unsigned char* lds, const Gemm g, const Sched& S, const Epi& E, int tid_in) {
    int tid_ = tid_in; asm volatile("" : "+v"(tid_));
    const int tid = tid_, wid = __builtin_amdgcn_readfirstlane(tid >> 6), lane = tid & 63, wr = wid >> 2, wc = wid & 3, fr = lane & 15, fq = lane >> 4;
    const int K = g.ld, nt = g.nt;
    unsigned voffA[2], voffB[2];
#pragma unroll
    for (int i = 0; i < 2; ++i) { int R, C; stage_rc(tid * 16 + i * 8192, R, C); const int Rb = (R & ~31) + perm32(R & 31);
        voffA[i] = (unsigned)(R * K + C) * 2u; voffB[i] = (unsigned)(Rb * K + C) * 2u; }
    const size_t kstep = (size_t)(BK * 2);
    const size_t hstep = (size_t)HALF * K * 2;
    const size_t tstep = 2 * hstep;
    const unsigned ldsw = (unsigned)wid * 1024u;
    const int aoff = lds_byte(wr * 64 + fr, fq * 8), boff = lds_byte(wc * 32 + fr, fq * 8);
#define PG8_SA(b, h) (((b) * 2 + (h)) * HTB)
#define PG8_SB(b, h) ((4 + (b) * 2 + (h)) * HTB)
#define PG8_STAGE(bufoff, gbase, voff) do { _Pragma("unroll") for (int _i = 0; _i < 2; ++_i) \
        __builtin_amdgcn_global_load_lds((const unsigned*)((const char*)(gbase) + (voff)[_i]), (LAS unsigned*)(lds + (bufoff) + ldsw + _i * 8192), 16, 0, 0); } while (0)
#define PG8_LDA(dst, b, h) do { _Pragma("unroll") for (int m = 0; m < 4; ++m) _Pragma("unroll") for (int k = 0; k < 2; ++k) dst[m][k] = *(const LAS bf16x8*)(lds + PG8_SA(b, h) + aoff + m * 2048 + k * 1024); } while (0)
#define PG8_LDB(dst, b, h) do { _Pragma("unroll") for (int n = 0; n < 2; ++n) _Pragma("unroll") for (int k = 0; k < 2; ++k) dst[n][k] = *(const LAS bf16x8*)(lds + PG8_SB(b, h) + boff + n * 2048 + k * 1024); } while (0)
#define PG8_MMA(ai, bj, At, Bt) do { __builtin_amdgcn_s_setprio(1); _Pragma("unroll") for (int m = 0; m < 4; ++m) _Pragma("unroll") for (int n = 0; n < 2; ++n) _Pragma("unroll") for (int k = 0; k < 2; ++k) \
        acc[ai][bj][m][n] = __builtin_amdgcn_mfma_f32_16x16x32_bf16(Bt[n][k], At[m][k], acc[ai][bj][m][n], 0, 0, 0); __builtin_amdgcn_s_setprio(0); } while (0)
#define PG8_WAIT_V(n) asm volatile("s_waitcnt vmcnt(" #n ")" ::: "memory")
#define PG8_WAIT_L(n) asm volatile("s_waitcnt lgkmcnt(" #n ")" ::: "memory")
#define PG8_BAR __builtin_amdgcn_s_barrier()
#define PG8_SCHED __builtin_amdgcn_sched_barrier(0)
    Unit cur, nxt; int ui = 0;
    if (!S.next(0, cur)) return;
    f32x4 acc[2][2][4][2];
#pragma unroll
    for (int a = 0; a < 2; ++a)
#pragma unroll
        for (int b = 0; b < 2; ++b)
#pragma unroll
            for (int m = 0; m < 4; ++m)
#pragma unroll
                for (int n = 0; n < 2; ++n) acc[a][b][m][n] = (f32x4){0.f, 0.f, 0.f, 0.f};
    bf16x8 At[4][2], B0[2][2], B1[2][2];
    const char* cA = (const char*)g.A + (size_t)cur.pm * tstep + cur.koff; const char* cB = (const char*)g.Bt + (size_t)cur.pn * tstep + cur.koff;
    PG8_STAGE(PG8_SB(0, 0), cB, voffB); PG8_STAGE(PG8_SB(0, 1), cB + hstep, voffB); PG8_STAGE(PG8_SA(0, 0), cA, voffA); PG8_STAGE(PG8_SA(0, 1), cA + hstep, voffA);
    if (wr == 1) PG8_BAR;
    PG8_WAIT_V(2); PG8_BAR;
    PG8_STAGE(PG8_SB(1, 0), cB + kstep, voffB); PG8_STAGE(PG8_SB(1, 1), cB + hstep + kstep, voffB);
    PG8_WAIT_V(4); PG8_BAR;
    for (;;) {
        const bool has_next = S.next(ui + 1, nxt);
        const char* nA = has_next ? (const char*)g.A + (size_t)nxt.pm * tstep + nxt.koff : cA; const char* nB = has_next ? (const char*)g.Bt + (size_t)nxt.pn * tstep + nxt.koff : cB;
        for (int t = 0; t < nt; t += 2) {
            const bool last = (t == nt - 2);
            const char* a1 = cA + (size_t)(t + 1) * kstep;
            const char* a2 = last ? nA : cA + (size_t)(t + 2) * kstep; const char* b2 = last ? nB : cB + (size_t)(t + 2) * kstep;
            const char* a3 = a2 + kstep; const char* b3 = b2 + kstep;
            PG8_LDB(B0, 0, 0); PG8_LDB(B1, 0, 1); PG8_SCHED; PG8_LDA(At, 0, 0); PG8_STAGE(PG8_SA(1, 0), a1, voffA); PG8_STAGE(PG8_SA(1, 1), a1 + hstep, voffA);
            PG8_WAIT_V(8); PG8_WAIT_L(0); PG8_BAR; PG8_MMA(0, 0, At, B0); PG8_MMA(0, 1, At, B1); PG8_BAR; PG8_SCHED;
            PG8_LDA(At, 0, 1); PG8_STAGE(PG8_SB(0, 0), b2, voffB); PG8_STAGE(PG8_SB(0, 1), b2 + hstep, voffB);
            PG8_WAIT_V(6); PG8_WAIT_L(0); PG8_BAR; PG8_MMA(1, 0, At, B0); PG8_MMA(1, 1, At, B1); PG8_BAR; PG8_SCHED;
            PG8_LDB(B0, 1, 0); PG8_LDB(B1, 1, 1); PG8_SCHED; PG8_LDA(At, 1, 0); PG8_STAGE(PG8_SA(0, 0), a2, voffA); PG8_STAGE(PG8_SA(0, 1), a2 + hstep, voffA);
            PG8_WAIT_V(8); PG8_WAIT_L(0); PG8_BAR; PG8_MMA(0, 0, At, B0); PG8_MMA(0, 1, At, B1); PG8_BAR; PG8_SCHED;
            PG8_LDA(At, 1, 1); PG8_STAGE(PG8_SB(1, 0), b3, voffB); PG8_STAGE(PG8_SB(1, 1), b3 + hstep, voffB);
            PG8_WAIT_V(6); PG8_WAIT_L(0); PG8_BAR; PG8_MMA(1, 0, At, B0); PG8_MMA(1, 1, At, B1); PG8_BAR; PG8_SCHED;
        }
        if (wr == 0) PG8_BAR;
        const bool keep = E(acc, cur, wr, wc, fr, fq);
        if (!has_next) break;
        if (!keep) {
#pragma unroll
            for (int a = 0; a < 2; ++a)
#pragma unroll
                for (int b = 0; b < 2; ++b)
#pragma unroll
                    for (int m = 0; m < 4; ++m)
#pragma unroll
                        for (int n = 0; n < 2; ++n) acc[a][b][m][n] = (f32x4){0.f, 0.f, 0.f, 0.f};
        }
        cur = nxt; cA = nA; cB = nB; ++ui;
        if (wr == 1) PG8_BAR;
    }
    PG8_WAIT_V(0);
    PG8_BAR;
#undef PG8_SA
#undef PG8_SB
#undef PG8_STAGE
#undef PG8_LDA
#undef PG8_LDB
#undef PG8_MMA
#undef PG8_WAIT_V
#undef PG8_WAIT_L
#undef PG8_BAR
#undef PG8_SCHED
}

struct EpiProj {
    unsigned char* ws;
    __device__ __forceinline__ bool operator()(f32x4 (&acc)[2][2][4][2], const Unit& u, int wr, int wc, int fr, int fq) const {
        const int pn = u.pn; const int row0 = u.pm * BM + wr * 64 + fr;
        if (pn < 5) {
            const float* rope = (const float*)(ws + WS_ROPE);
            const bool isq = pn < 4;
            bf16_t* O = (bf16_t*)(ws + (isq ? WS_Q : WS_K)); const int ldo = isq ? 1024 : 256, hcol = isq ? (pn * 4 + wc) * 64 : wc * 64; const float sc = isq ? 0.125f : 1.0f;
#pragma unroll
            for (int ai = 0; ai < 2; ++ai) {
                f32x4 tb[4][4];
#pragma unroll
                for (int m = 0; m < 4; ++m) { const f32x4* rp = (const f32x4*)(rope + (size_t)(row0 + ai * HALF + m * 16) * 64 + 8 * fq); tb[m][0] = rp[0]; tb[m][1] = rp[1]; tb[m][2] = rp[8]; tb[m][3] = rp[9]; }
#pragma unroll
                for (int m = 0; m < 4; ++m) {
                    const int row = row0 + ai * HALF + m * 16;
                    const f32x4 c0 = tb[m][0], c1 = tb[m][1], s0 = tb[m][2], s1 = tb[m][3];
                    const f32x4 x1a = acc[ai][0][m][0], x1b = acc[ai][0][m][1], x2a = acc[ai][1][m][0], x2b = acc[ai][1][m][1];
                    const f32x4 o1a = (x1a * c0 - x2a * s0) * sc, o1b = (x1b * c1 - x2b * s1) * sc;
                    const f32x4 o2a = (x2a * c0 + x1a * s0) * sc, o2b = (x2b * c1 + x1b * s1) * sc;
                    bf16_t* op = O + (size_t)row * ldo + hcol + 8 * fq;
                    *(u32x4*)op = pack8(o1a, o1b); *(u32x4*)(op + 32) = pack8(o2a, o2b);
                }
            }
        } else if (pn == 5 || (pn >= 14 && pn < 18)) {
            bf16_t* O = (bf16_t*)(ws + ((pn == 5) ? WS_VT : WS_HVT + (size_t)(pn - 14) * 256 * T * 2));
#pragma unroll
            for (int bj = 0; bj < 2; ++bj)
#pragma unroll
                for (int n = 0; n < 2; ++n)
#pragma unroll
                    for (int i = 0; i < 4; ++i) {
                        const int col = bj * HALF + wc * 32 + 8 * fq + 4 * n + i;
                        bf16_t* op = O + (size_t)col * T + row0;
#pragma unroll
                        for (int ai = 0; ai < 2; ++ai)
#pragma unroll
                            for (int m = 0; m < 4; ++m) op[ai * HALF + m * 16] = (bf16_t)f2bf(acc[ai][bj][m][n][i]);
                    }
        } else {
            if (pn >= 22) {
                bf16_t* OR = (bf16_t*)(ws + WS_GSA); bf16_t* OB = (bf16_t*)(ws + WS_GSB);
#pragma unroll
                for (int ai = 0; ai < 2; ++ai)
#pragma unroll
                    for (int m = 0; m < 4; ++m) {
                        const size_t o = (size_t)(row0 + ai * HALF + m * 16) * DM + (pn - 22) * HALF + wc * 32 + 8 * fq;
                        f32x4 r[2], b[2];
#pragma unroll
                        for (int n = 0; n < 2; ++n)
#pragma unroll
                            for (int i = 0; i < 4; ++i) { const float ea = __expf(-acc[ai][0][m][n][i]), eb = __expf(-acc[ai][1][m][n][i]); b[n][i] = __builtin_amdgcn_rcpf(1.0f + eb); r[n][i] = (1.0f + eb) * __builtin_amdgcn_rcpf(1.0f + ea); }
                        *(u32x4*)(OR + o) = pack8(r[0], r[1]); *(u32x4*)(OB + o) = pack8(b[0], b[1]);
                    }
                return false;
            }
            size_t ooff; int ldo, cb; int mode;
            if (pn < 10) { ooff = WS_HQ; ldo = 1024; cb = (pn - 6) * 256; mode = 3; }
            else if (pn < 14) { ooff = WS_HZ; ldo = 1024; cb = (pn - 10) * 256; mode = 0; }
            else if (pn < 22) { ooff = WS_HG; ldo = 1024; cb = (pn - 18) * 256; mode = 2; }
            else if (pn < 30) { ooff = WS_GSA; ldo = 2048; cb = (pn - 22) * 256; mode = 1; }
            else { ooff = WS_GSB; ldo = 2048; cb = (pn - 30) * 256; mode = 1; }
            bf16_t* O = (bf16_t*)(ws + ooff);
            const float osc = (mode == 3) ? 0.08838834764831845f : 1.0f;
#pragma unroll
            for (int ai = 0; ai < 2; ++ai)
#pragma unroll
                for (int m = 0; m < 4; ++m) {
                    bf16_t* rowp = O + (size_t)(row0 + ai * HALF + m * 16) * ldo + cb + wc * 32 + 8 * fq;
#pragma unroll
                    for (int bj = 0; bj < 2; ++bj) {
                        f32x4 v[2] = {acc[ai][bj][m][0], acc[ai][bj][m][1]};
#pragma unroll
                        for (int n = 0; n < 2; ++n)
#pragma unroll
                            for (int i = 0; i < 4; ++i) { const float x = v[n][i]; const float s = sigmoidf_(x); v[n][i] = (mode == 0) ? x : (mode == 1) ? s : x * s * osc; }
                        *(u32x4*)(rowp + bj * HALF) = pack8(v[0], v[1]);
                    }
                }
        }
        return false;
    }
};
struct EpiMerged {
    const bf16_t *GSA, *GSB; bf16_t* O;
    __device__ __forceinline__ bool operator()(f32x4 (&acc)[2][2][4][2], const Unit& u, int wr, int wc, int fr, int fq) const {
        const int row0 = u.pm * BM + wr * 64 + fr, col0 = u.pn * BM + wc * 32 + 8 * fq;
        const bf16_t* G = (u.half == 0) ? GSA : GSB;
#pragma unroll
        for (int ai = 0; ai < 2; ++ai) {
            u32x4 gv[4][2];
#pragma unroll
            for (int m = 0; m < 4; ++m)
#pragma unroll
                for (int bj = 0; bj < 2; ++bj) gv[m][bj] = *(const u32x4*)(G + (size_t)(row0 + ai * HALF + m * 16) * DM + col0 + bj * HALF);
#pragma unroll
            for (int m = 0; m < 4; ++m)
#pragma unroll
                for (int bj = 0; bj < 2; ++bj) {
                    const u32x4 gw = gv[m][bj];
                    const float fg[8] = {bflo(gw.x), bfhi(gw.x), bflo(gw.y), bfhi(gw.y), bflo(gw.z), bfhi(gw.z), bflo(gw.w), bfhi(gw.w)};
#pragma unroll
                    for (int n = 0; n < 2; ++n)
#pragma unroll
                        for (int i = 0; i < 4; ++i) acc[ai][bj][m][n][i] *= fg[4 * n + i];
                    if (u.half != 0) *(u32x4*)(O + (size_t)(row0 + ai * HALF + m * 16) * DM + col0 + bj * HALF) = pack8(acc[ai][bj][m][0], acc[ai][bj][m][1]);
                }
        }
        return u.half == 0;
    }
};
struct EpiRowSS {
    float* Y; float* part;
    __device__ __forceinline__ bool operator()(f32x4 (&acc)[2][2][4][2], const Unit& u, int wr, int wc, int fr, int fq) const {
        const int row0 = u.pm * BM + wr * 64 + fr, col0 = u.pn * BM + wc * 32 + 8 * fq;
#pragma unroll
        for (int ai = 0; ai < 2; ++ai)
#pragma unroll
            for (int m = 0; m < 4; ++m) {
                const int row = row0 + ai * HALF + m * 16; float ss = 0.f;
#pragma unroll
                for (int bj = 0; bj < 2; ++bj) {
                    const f32x4 v0 = acc[ai][bj][m][0], v1 = acc[ai][bj][m][1];
                    float* yp = Y + (size_t)row * DM + col0 + bj * HALF;
                    *(f32x4*)yp = v0; *(f32x4*)(yp + 4) = v1;
                    ss += (v0[0] * v0[0] + v0[1] * v0[1]) + (v0[2] * v0[2] + v0[3] * v0[3]) + (v1[0] * v1[0] + v1[1] * v1[1]) + (v1[2] * v1[2] + v1[3] * v1[3]);
                }
                ss += __shfl_xor(ss, 16); ss += __shfl_xor(ss, 32);
                if (fq == 0) part[(size_t)row * 32 + u.pn * 4 + wc] = ss;
            }
        return false;
    }
};
struct EpiRowSSb {
    bf16_t* Y; float* part;
    __device__ __forceinline__ bool operator()(f32x4 (&acc)[2][2][4][2], const Unit& u, int wr, int wc, int fr, int fq) const {
        const int row0 = u.pm * BM + wr * 64 + fr, col0 = u.pn * BM + wc * 32 + 8 * fq;
#pragma unroll
        for (int ai = 0; ai < 2; ++ai)
#pragma unroll
            for (int m = 0; m < 4; ++m) {
                const int row = row0 + ai * HALF + m * 16; float ss = 0.f;
#pragma unroll
                for (int bj = 0; bj < 2; ++bj) {
                    const f32x4 v0 = acc[ai][bj][m][0], v1 = acc[ai][bj][m][1];
                    *(u32x4*)(Y + (size_t)row * DM + col0 + bj * HALF) = pack8(v0, v1);
                    ss += (v0[0] * v0[0] + v0[1] * v0[1]) + (v0[2] * v0[2] + v0[3] * v0[3]) + (v1[0] * v1[0] + v1[1] * v1[1]) + (v1[2] * v1[2] + v1[3] * v1[3]);
                }
                ss += __shfl_xor(ss, 16); ss += __shfl_xor(ss, 32);
                if (fq == 0) part[(size_t)row * 32 + u.pn * 4 + wc] = ss;
            }
        return false;
    }
};
struct EpiSwiglu {
    bf16_t* O;
    __device__ __forceinline__ bool operator()(f32x4 (&acc)[2][2][4][2], const Unit& u, int wr, int wc, int fr, int fq) const {
        const int row0 = u.pm * BM + wr * 64 + fr, col0 = u.pn * HALF + wc * 32 + 8 * fq;
#pragma unroll
        for (int ai = 0; ai < 2; ++ai)
#pragma unroll
            for (int m = 0; m < 4; ++m) {
                f32x4 v[2];
#pragma unroll
                for (int n = 0; n < 2; ++n)
#pragma unroll
                    for (int i = 0; i < 4; ++i) { const float gx = acc[ai][0][m][n][i]; v[n][i] = gx * sigmoidf_(gx) * acc[ai][1][m][n][i]; }
                *(u32x4*)(O + (size_t)(row0 + ai * HALF + m * 16) * DFF + col0) = pack8(v[0], v[1]);
            }
        return false;
    }
};
struct EpiE0 {
    bf16_t* E0;
    __device__ __forceinline__ bool operator()(f32x4 (&acc)[2][2][4][2], const Unit& u, int wr, int wc, int fr, int fq) const {
        const int row0 = u.pm * BM + wr * 64 + fr, col0 = u.pn * BM + wc * 32 + 8 * fq;
#pragma unroll
        for (int ai = 0; ai < 2; ++ai)
#pragma unroll
            for (int m = 0; m < 4; ++m)
#pragma unroll
                for (int bj = 0; bj < 2; ++bj)
                    *(u32x4*)(E0 + (size_t)(row0 + ai * HALF + m * 16) * DM + col0 + bj * HALF) = pack8(acc[ai][bj][m][0], acc[ai][bj][m][1]);
        return false;
    }
};
struct EpiPle {
    const bf16_t* E0; bf16_t* Y; float* part;
    __device__ __forceinline__ bool operator()(f32x4 (&acc)[2][2][4][2], const Unit& u, int wr, int wc, int fr, int fq) const {
        const int row0 = u.pm * BM + wr * 64 + fr, col0 = u.pn * BM + wc * 32 + 8 * fq;
#pragma unroll
        for (int ai = 0; ai < 2; ++ai)
#pragma unroll
            for (int m = 0; m < 4; ++m) {
                const int row = row0 + ai * HALF + m * 16; float ss = 0.f;
#pragma unroll
                for (int bj = 0; bj < 2; ++bj) {
                    const size_t off = (size_t)row * DM + col0 + bj * HALF;
                    const u32x4 eb = *(const u32x4*)(E0 + off);
                    const float fe[8] = {bflo(eb.x), bfhi(eb.x), bflo(eb.y), bfhi(eb.y), bflo(eb.z), bfhi(eb.z), bflo(eb.w), bfhi(eb.w)};
                    f32x4 v[2];
#pragma unroll
                    for (int n = 0; n < 2; ++n)
#pragma unroll
                        for (int i = 0; i < 4; ++i) { const float e = fe[4 * n + i] * sigmoidf_(acc[ai][bj][m][n][i]); v[n][i] = e; ss += e * e; }
                    *(u32x4*)(Y + off) = pack8(v[0], v[1]);
                }
                ss += __shfl_xor(ss, 16); ss += __shfl_xor(ss, 32);
                if (fq == 0) part[(size_t)row * 32 + u.pn * 4 + wc] = ss;
            }
        return false;
    }
};
}

__device__ __forceinline__ void transpose_item(const float* W, int N, bf16_t* WT, int dst_ld, int dst_row0, int dst_k0, int k0, int n0, LAS float* scr, int lane) {
#pragma unroll 8
    for (int i = 0; i < 32; ++i) { const int kk = 2 * i + (lane >> 5); scr[kk * 33 + (lane & 31)] = W[(size_t)(k0 + kk) * N + n0 + (lane & 31)]; }
    asm volatile("s_waitcnt lgkmcnt(0)" ::: "memory");
    const int c = lane & 7;
#pragma unroll
    for (int j = 0; j < 4; ++j) { const int n = (lane >> 3) + 8 * j; const LAS float* s = scr + (8 * c) * 33 + n;
        u32x4 o; o.x = pk2(s[0 * 33], s[1 * 33]); o.y = pk2(s[2 * 33], s[3 * 33]); o.z = pk2(s[4 * 33], s[5 * 33]); o.w = pk2(s[6 * 33], s[7 * 33]);
        *(u32x4*)(WT + (size_t)(dst_row0 + n) * dst_ld + dst_k0 + 8 * c) = o; }
    asm volatile("s_waitcnt lgkmcnt(0)" ::: "memory");
}
__device__ __forceinline__ void rms_row_to_bf16(const float* xrow, const float* gain, bf16_t* orow, int lane) {
    const f32x4* xr = (const f32x4*)xrow + lane; const f32x4* gr = (const f32x4*)gain + lane;
    f32x4 v[8]; float s = 0.f;
#pragma unroll
    for (int j = 0; j < 8; ++j) { v[j] = xr[64 * j]; s += (v[j][0] * v[j][0] + v[j][1] * v[j][1]) + (v[j][2] * v[j][2] + v[j][3] * v[j][3]); }
    const float rstd = rsqrtf(wave_sum(s) * (1.0f / DM) + RMS_EPS);
    u32x2* o8 = (u32x2*)orow + lane;
#pragma unroll
    for (int j = 0; j < 8; ++j) { const f32x4 g = gr[64 * j]; u32x2 w; w.x = pk2(v[j][0] * rstd * g[0], v[j][1] * rstd * g[1]); w.y = pk2(v[j][2] * rstd * g[2], v[j][3] * rstd * g[3]); o8[64 * j] = w; }
}
template <bool XIB, bool XOB> __device__ __forceinline__ void rowpass(const bf16_t* Y, const float* part, const void* Xin, void* Xout, const float* g_post, const float* g_pre, bf16_t* Hout, int gw, int ngw, int lane_) {
    int lane = lane_; asm volatile("" : "+v"(lane));
    f32x4 gp[8];
#pragma unroll
    for (int j = 0; j < 8; ++j) gp[j] = ((const f32x4*)g_post)[lane + 64 * j];
    u32x2 ny[8]; f32x4 nxf[8]; u32x2 nxb[8]; float np = 0.f;
#define RP_LOAD(r) do { np = part[(size_t)(r) * 32 + (lane & 31)]; \
        const u32x2* yb_ = (const u32x2*)(Y + (size_t)(r) * DM) + lane; \
        _Pragma("unroll") for (int j = 0; j < 8; ++j) { ny[j] = yb_[64 * j]; \
            if (XIB) nxb[j] = ((const u32x2*)((const bf16_t*)Xin + (size_t)(r) * DM) + lane)[64 * j]; else nxf[j] = ((const f32x4*)((const float*)Xin + (size_t)(r) * DM) + lane)[64 * j]; } } while (0)
    int row = gw;
    if (row < T) RP_LOAD(row);
    for (; row < T; row += ngw) {
        u32x2 cy[8]; f32x4 cx[8]; float p = np;
#pragma unroll
        for (int j = 0; j < 8; ++j) { cy[j] = ny[j]; if (XIB) cx[j] = (f32x4){bflo(nxb[j].x), bfhi(nxb[j].x), bflo(nxb[j].y), bfhi(nxb[j].y)}; else cx[j] = nxf[j]; }
        if (row + ngw < T) RP_LOAD(row + ngw);
#pragma unroll
        for (int o = 1; o < 32; o <<= 1) p += __shfl_xor(p, o);
        const float rstd = rsqrtf(p * (1.0f / DM) + RMS_EPS);
        f32x4* of = (f32x4*)((float*)Xout + (size_t)row * DM) + lane; u32x2* ob = (u32x2*)((bf16_t*)Xout + (size_t)row * DM) + lane;
        f32x4 v[8]; float s = 0.f;
#pragma unroll
        for (int j = 0; j < 8; ++j) {
            const f32x4 y = {bflo(cy[j].x), bfhi(cy[j].x), bflo(cy[j].y), bfhi(cy[j].y)};
            v[j] = cx[j] + y * rstd * gp[j];
            if (XOB) { u32x2 o2; o2.x = pk2(v[j][0], v[j][1]); o2.y = pk2(v[j][2], v[j][3]); ob[64 * j] = o2; } else of[64 * j] = v[j];
            s += (v[j][0] * v[j][0] + v[j][1] * v[j][1]) + (v[j][2] * v[j][2] + v[j][3] * v[j][3]);
        }
        if (Hout) {
            const float r2 = rsqrtf(wave_sum(s) * (1.0f / DM) + RMS_EPS);
            const f32x4* gq = (const f32x4*)g_pre + lane; u32x2* o8 = (u32x2*)(Hout + (size_t)row * DM) + lane;
#pragma unroll
            for (int j = 0; j < 8; ++j) { const f32x4 g = gq[64 * j]; u32x2 w; w.x = pk2(v[j][0] * r2 * g[0], v[j][1] * r2 * g[1]); w.y = pk2(v[j][2] * r2 * g[2], v[j][3] * r2 * g[3]); o8[64 * j] = w; }
        }
    }
#undef RP_LOAD
}

#define LDS_BAR do { asm volatile("s_waitcnt lgkmcnt(0)" ::: "memory"); __builtin_amdgcn_s_barrier(); asm volatile("" ::: "memory"); } while (0)
__device__ __forceinline__ void attn_units(LAS unsigned char* lds, const bf16_t* Q, const bf16_t* Kk, const bf16_t* VT, const float* sinks, bf16_t* Y, int bid, int G, int tid) {
    const int lane = tid & 63, wave = tid >> 6, g = lane >> 4, n = lane & 15;
    LAS bf16_t* KL = (LAS bf16_t*)lds;
    LAS bf16_t* VL = (LAS bf16_t*)(lds + 36864);
    for (int it = bid; it < 512; it += G) {
        const int kvh = it & 3, blk = (it >> 2) & 63, b = it >> 8, s0 = blk * 128 + wave * 16, ks = blk * 128 - 128; const size_t tokb = (size_t)b * SEQ;
        u32x4 kst[4], vst[4];
#pragma unroll
        for (int ps = 0; ps < 4; ++ps) { const int row = ps * 64 + (tid >> 3), kr = ks + row; kst[ps] = *(const u32x4*)(Kk + (tokb + (kr < 0 ? 0 : kr)) * 256 + kvh * 64 + 8 * (tid & 7)); }
#pragma unroll
        for (int ps = 0; ps < 4; ++ps) { const int row = ps * 16 + (tid >> 5), kc = ks + 8 * (tid & 31); vst[ps] = *(const u32x4*)(VT + (size_t)(kvh * 64 + row) * T + tokb + (kc < 0 ? 0 : kc)); }
        const bf16_t* qp = Q + (tokb + s0 + n) * 1024 + (kvh * 4) * 64 + 8 * g;
        bf16x8 qf[2];
        qf[0] = *(const bf16x8*)qp; qf[1] = *(const bf16x8*)(qp + 32);
#pragma unroll
        for (int ps = 0; ps < 4; ++ps) *(LAS u32x4*)(KL + (ps * 64 + (tid >> 3)) * 72 + 8 * (tid & 7)) = kst[ps];
#pragma unroll
        for (int ps = 0; ps < 4; ++ps) *(LAS u32x4*)(VL + (ps * 16 + (tid >> 5)) * 264 + 8 * (tid & 31)) = vst[ps];
        __syncthreads();
        bf16x8 kf[9][2];
#pragma unroll
        for (int j = 0; j < 9; ++j) { const LAS bf16_t* kp = KL + (16 * wave + 16 * j + n) * 72 + 8 * g; kf[j][0] = *(const LAS bf16x8*)kp; kf[j][1] = *(const LAS bf16x8*)(kp + 32); }
        bf16x8 pf[4][5]; float inv[4];
#pragma unroll
        for (int hh = 0; hh < 4; ++hh) {
            f32x4 sc[9];
#pragma unroll
            for (int j = 0; j < 9; ++j) { f32x4 a = {0.f, 0.f, 0.f, 0.f}; a = mfma16(kf[j][0], qf[0], a); a = mfma16(kf[j][1], qf[1], a); sc[j] = a; }
            if (hh < 3) { qf[0] = *(const bf16x8*)(qp + (hh + 1) * 64); qf[1] = *(const bf16x8*)(qp + (hh + 1) * 64 + 32); }
            const float sink = sinks[kvh * 4 + hh];
            float mx = sink;
#pragma unroll
            for (int j = 0; j < 9; ++j) {
                const int key0 = s0 - 128 + 16 * j;
#pragma unroll
                for (int i = 0; i < 4; ++i) {
                    const int kr = 4 * g + i;
                    bool valid = key0 >= 0;
                    if (j == 0) valid = valid && (kr >= n + 1);
                    if (j == 8) valid = valid && (kr <= n);
                    const float v = valid ? sc[j][i] : -1e30f;
                    sc[j][i] = v; mx = fmaxf(mx, v);
                }
            }
            mx = fmaxf(mx, __shfl_xor(mx, 16)); mx = fmaxf(mx, __shfl_xor(mx, 32));
            float l = 0.f;
#pragma unroll
            for (int j = 0; j < 9; ++j)
#pragma unroll
                for (int i = 0; i < 4; ++i) { const float p = __expf(sc[j][i] - mx); sc[j][i] = p; l += p; }
            l += __shfl_xor(l, 16); l += __shfl_xor(l, 32);
            l += __expf(sink - mx);
            inv[hh] = 1.0f / l;
#pragma unroll
            for (int ks5 = 0; ks5 < 5; ++ks5) {
                const f32x4 pa = sc[2 * ks5]; const f32x4 pb = (2 * ks5 + 1 < 9) ? sc[(2 * ks5 + 1 < 9) ? 2 * ks5 + 1 : 0] : (f32x4){0.f, 0.f, 0.f, 0.f};
                u32x4 w; w.x = pk2_sw(pa[0], pa[1]); w.y = pk2_sw(pa[2], pa[3]); w.z = pk2_sw(pb[0], pb[1]); w.w = pk2_sw(pb[2], pb[3]);
                pf[hh][ks5] = __builtin_bit_cast(bf16x8, w);
            }
        }
#pragma unroll
        for (int dt = 0; dt < 4; ++dt) {
            const LAS bf16_t* vrow = VL + (dt * 16 + n) * 264 + 16 * wave + 4 * g;
            bf16x8 vf[5];
#pragma unroll
            for (int ks5 = 0; ks5 < 5; ++ks5) {
                const u32x2 va = *(const LAS u32x2*)(vrow + 32 * ks5);
                u32x2 vb = {0u, 0u}; if (ks5 < 4) vb = *(const LAS u32x2*)(vrow + 32 * ks5 + 16);
                u32x4 w; w.x = va.x; w.y = va.y; w.z = vb.x; w.w = vb.y; vf[ks5] = __builtin_bit_cast(bf16x8, w);
            }
#pragma unroll
            for (int hh = 0; hh < 4; ++hh) {
                f32x4 acc = {0.f, 0.f, 0.f, 0.f};
#pragma unroll
                for (int ks5 = 0; ks5 < 5; ++ks5) acc = mfma16(vf[ks5], pf[hh][ks5], acc);
                u32x2 o; o.x = pk2_sw(acc[0] * inv[hh], acc[1] * inv[hh]); o.y = pk2_sw(acc[2] * inv[hh], acc[3] * inv[hh]);
                *(u32x2*)(Y + (tokb + s0 + n) * DM + (kvh * 4 + hh) * 64 + dt * 16 + 4 * g) = o;
            }
        }
        __syncthreads();
    }
}

__device__ __forceinline__ void hgrn_passA_units(LAS unsigned char* lds, const bf16_t* HZ, const bf16_t* HVT, const float* LB, bf16_t* U, float* DC, int bid, int G, int tid) {
    const int k = tid & 127, I = tid >> 7, lane = tid & 63, w = tid >> 6, g = lane >> 4, n = lane & 15;
    LAS float* TOT = (LAS float*)lds;
    LAS bf16_t* KT = (LAS bf16_t*)(lds + 2048);
    LAS bf16_t* VS = (LAS bf16_t*)(lds + 2048 + 18432);
#define PA_DECODE(r_) const int h = (r_) & 7, c = ((r_) >> 3) & 127, b = (r_) >> 10; const size_t tok0 = (size_t)b * SEQ + (size_t)c * 64; const int ch = (b * 8 + h) * 128 + c;
#define PA_LOADZ(r_) do { PA_DECODE(r_) (void)ch; _Pragma("unroll") for (int i = 0; i < 16; ++i) zn[i] = HZ[(tok0 + 16 * I + i) * 1024 + h * 128 + k]; } while (0)
    unsigned short zn[16];
    int r = bid;
    if (r >= 2048) return;
    PA_LOADZ(r);
    for (; r < 2048; r += G) {
        PA_DECODE(r)
        const float lb = LB[h * 128 + k], oml = 1.0f - lb;
        unsigned short zc[16];
#pragma unroll
        for (int i = 0; i < 16; ++i) zc[i] = zn[i];
        u32x4 vst[2];
#pragma unroll
        for (int ps = 0; ps < 2; ++ps) vst[ps] = *(const u32x4*)(HVT + (size_t)(h * 128 + 64 * ps + (tid >> 3)) * T + tok0 + 8 * (tid & 7));
        if (r + G < 2048) PA_LOADZ(r + G);
        float cs[16], kk[16]; float run = 0.f;
#pragma unroll
        for (int i = 0; i < 16; ++i) {
            const float z = bf2f(zc[i]);
            const float e = __expf(-z), s = __builtin_amdgcn_rcpf(1.0f + e);
            run += __logf(lb + oml * s); cs[i] = run; kk[i] = oml * e * s;
        }
        TOT[I * 128 + k] = run;
        LDS_BAR;
        const float t0 = TOT[k], t1 = TOT[128 + k], t2 = TOT[256 + k], t3 = TOT[384 + k];
        const float rI = (I > 0 ? t0 : 0.f) + (I > 1 ? t1 : 0.f) + (I > 2 ? t2 : 0.f);
        const float blast = (t0 + t1) + (t2 + t3);
        unsigned pw[8];
#pragma unroll
        for (int i = 0; i < 8; ++i) pw[i] = pk2(kk[2 * i] * __expf(blast - rI - cs[2 * i]), kk[2 * i + 1] * __expf(blast - rI - cs[2 * i + 1]));
        LAS u32x4* kd = (LAS u32x4*)(KT + k * 72 + 16 * I);
        kd[0] = (u32x4){pw[0], pw[1], pw[2], pw[3]}; kd[1] = (u32x4){pw[4], pw[5], pw[6], pw[7]};
        if (I == 0) DC[(size_t)ch * 128 + k] = __expf(blast);
#pragma unroll
        for (int ps = 0; ps < 2; ++ps) *(LAS u32x4*)(VS + (64 * ps + (tid >> 3)) * 72 + 8 * (tid & 7)) = vst[ps];
        LDS_BAR;
        f32x4 acc[8];
#pragma unroll
        for (int d = 0; d < 8; ++d) acc[d] = (f32x4){0.f, 0.f, 0.f, 0.f};
#pragma unroll
        for (int st = 0; st < 2; ++st) {
            const bf16x8 a = *(const LAS bf16x8*)(KT + (16 * w + n) * 72 + 32 * st + 8 * g);
#pragma unroll
            for (int d = 0; d < 8; ++d) acc[d] = mfma16(a, *(const LAS bf16x8*)(VS + (16 * d + n) * 72 + 32 * st + 8 * g), acc[d]);
        }
#pragma unroll
        for (int d = 0; d < 8; ++d) { u32x2 o; o.x = pk2(acc[d][0], acc[d][1]); o.y = pk2(acc[d][2], acc[d][3]); *(u32x2*)(U + (size_t)ch * 16384 + (size_t)(16 * d + n) * 128 + 16 * w + 4 * g) = o; }
        LDS_BAR;
    }
#undef PA_DECODE
#undef PA_LOADZ
}

__device__ __forceinline__ void hgrn_passC(LAS unsigned char* lds, const bf16_t* HQ, const bf16_t* HZ, const bf16_t* HVT, const bf16_t* HG, const float* LB, const bf16_t* ST,
                                           const float* gnorm, bf16_t* Y, int b, int c, int h, int tid) {
    const int kp = tid & 63, sb = tid >> 6, I = sb >> 1, hf = sb & 1, lane = tid & 63, w = tid >> 6, g = lane >> 4, n = lane & 15;
    const size_t tok0 = (size_t)b * SEQ + (size_t)c * 64; const int ch = (b * 8 + h) * 128 + c;
    LAS float* TOT = (LAS float*)lds;
    LAS float* SS = (LAS float*)(lds + 4096);
    LAS bf16_t* QE = (LAS bf16_t*)(lds + 4608);
    LAS bf16_t* QI = QE + 64 * 136;
    LAS bf16_t* KB = QI + 64 * 136;
    LAS bf16_t* STS = (LAS bf16_t*)(lds + 82944);
    LAS bf16_t* VS = (LAS bf16_t*)(lds + 117760);
    const f32x2 lb2 = *(const f32x2*)(LB + h * 128 + 2 * kp);
    const int Iw = w & 3, dvh = w >> 2;
    unsigned zr[8], qr[8];
#pragma unroll
    for (int i = 0; i < 8; ++i) { zr[i] = *(const unsigned*)(HZ + (tok0 + 8 * sb + i) * 1024 + h * 128 + 2 * kp); qr[i] = *(const unsigned*)(HQ + (tok0 + 8 * sb + i) * 1024 + h * 128 + 2 * kp); }
    u32x4 sts[4], vst[2]; u32x2 hgv[4];
#pragma unroll
    for (int ps = 0; ps < 4; ++ps) sts[ps] = *(const u32x4*)(ST + (size_t)ch * 16384 + (size_t)(32 * ps + (tid >> 4)) * 128 + 8 * (tid & 15));
#pragma unroll
    for (int ps = 0; ps < 2; ++ps) vst[ps] = *(const u32x4*)(HVT + (size_t)(h * 128 + 64 * ps + (tid >> 3)) * T + tok0 + 8 * (tid & 7));
#pragma unroll
    for (int d4 = 0; d4 < 4; ++d4) hgv[d4] = *(const u32x2*)(HG + (tok0 + 16 * Iw + n) * 1024 + h * 128 + 16 * (4 * dvh + d4) + 4 * g);
    float cs[2][8], kk[2][8]; float run[2] = {0.f, 0.f};
#pragma unroll
    for (int i = 0; i < 8; ++i)
#pragma unroll
        for (int cc = 0; cc < 2; ++cc) {
            const float z = cc ? bfhi(zr[i]) : bflo(zr[i]); const float lb = lb2[cc], oml = 1.0f - lb;
            const float e = __expf(-z), s_ = __builtin_amdgcn_rcpf(1.0f + e);
            run[cc] += __logf(lb + oml * s_); cs[cc][i] = run[cc]; kk[cc][i] = oml * e * s_;
        }
    *(LAS f32x2*)(TOT + sb * 128 + 2 * kp) = (f32x2){run[0], run[1]};
    __syncthreads();
    f32x2 tt[7];
#pragma unroll
    for (int j = 0; j < 7; ++j) tt[j] = *(const LAS f32x2*)(TOT + j * 128 + 2 * kp);
    float eI[2], fI[2][4], pre[2];
#pragma unroll
    for (int cc = 0; cc < 2; ++cc) {
        const float r1 = tt[0][cc] + tt[1][cc], r2 = r1 + tt[2][cc] + tt[3][cc], r3 = r2 + tt[4][cc] + tt[5][cc];
        const float rI = (I == 0) ? 0.f : (I == 1) ? r1 : (I == 2) ? r2 : r3;
        const float tfirst = (I == 0) ? tt[0][cc] : (I == 1) ? tt[2][cc] : (I == 2) ? tt[4][cc] : tt[6][cc];
        pre[cc] = hf ? tfirst : 0.f;
        eI[cc] = __expf(rI);
        fI[cc][0] = __expf(0.f - rI); fI[cc][1] = __expf(r1 - rI); fI[cc][2] = __expf(r2 - rI); fI[cc][3] = __expf(r3 - rI);
    }
#pragma unroll
    for (int i = 0; i < 8; ++i) {
        const int t = 8 * sb + i, rowb = 8 * hf + i;
        float qi[2], kinv[2];
#pragma unroll
        for (int cc = 0; cc < 2; ++cc) { const float ecs = __expf(pre[cc] + cs[cc][i]); qi[cc] = (cc ? bfhi(qr[i]) : bflo(qr[i])) * ecs; kinv[cc] = kk[cc][i] * __builtin_amdgcn_rcpf(ecs); }
        *(LAS unsigned*)(QE + t * 136 + 2 * kp) = cvtpk_(qi[0] * eI[0], qi[1] * eI[1]);
        *(LAS unsigned*)(QI + t * 136 + 2 * kp) = cvtpk_(qi[0], qi[1]);
#pragma unroll
        for (int Ip = 0; Ip < 4; ++Ip) {
            if (Ip >= I) {
                const int blk = Ip * (Ip + 1) / 2 + I;
                *(LAS unsigned*)(KB + (blk * 16 + rowb) * 136 + 2 * kp) = cvtpk_(kinv[0] * fI[0][Ip], kinv[1] * fI[1][Ip]);
            }
        }
    }
#pragma unroll
    for (int ps = 0; ps < 4; ++ps) *(LAS u32x4*)(STS + (32 * ps + (tid >> 4)) * 136 + 8 * (tid & 15)) = sts[ps];
#pragma unroll
    for (int ps = 0; ps < 2; ++ps) *(LAS u32x4*)(VS + (64 * ps + (tid >> 3)) * 72 + 8 * (tid & 7)) = vst[ps];
    __syncthreads();
    f32x4 at[4];
#pragma unroll
    for (int J = 0; J < 4; ++J) {
        f32x4 a4 = {0.f, 0.f, 0.f, 0.f};
        if (J <= Iw) {
            const int blk = Iw * (Iw + 1) / 2 + J;
#pragma unroll
            for (int st = 0; st < 4; ++st) {
                const bf16x8 a = *(const LAS bf16x8*)(KB + (blk * 16 + n) * 136 + 32 * st + 8 * g);
                const bf16x8 bq = *(const LAS bf16x8*)(QI + (16 * Iw + n) * 136 + 32 * st + 8 * g);
                a4 = mfma16(a, bq, a4);
            }
            if (J == Iw) {
#pragma unroll
                for (int i = 0; i < 4; ++i) if (4 * g + i > n) a4[i] = 0.f;
            }
        }
        at[J] = a4;
    }
    bf16x8 pf[2];
#pragma unroll
    for (int ks = 0; ks < 2; ++ks) { u32x4 wv; wv.x = pk2(at[2 * ks][0], at[2 * ks][1]); wv.y = pk2(at[2 * ks][2], at[2 * ks][3]); wv.z = pk2(at[2 * ks + 1][0], at[2 * ks + 1][1]); wv.w = pk2(at[2 * ks + 1][2], at[2 * ks + 1][3]);
        pf[ks] = __builtin_bit_cast(bf16x8, wv); }
    f32x4 o[4]; float ss = 0.f;
#pragma unroll
    for (int d4 = 0; d4 < 4; ++d4) {
        f32x4 acc = {0.f, 0.f, 0.f, 0.f};
#pragma unroll
        for (int st = 0; st < 4; ++st) {
            const bf16x8 bq = *(const LAS bf16x8*)(QE + (16 * Iw + n) * 136 + 32 * st + 8 * g);
            acc = mfma16(*(const LAS bf16x8*)(STS + (16 * (4 * dvh + d4) + n) * 136 + 32 * st + 8 * g), bq, acc);
        }
        const LAS bf16_t* vl = VS + (16 * (4 * dvh + d4) + n) * 72 + 4 * g;
        { const u32x2 v0 = *(const LAS u32x2*)vl, v1 = *(const LAS u32x2*)(vl + 16); u32x4 wv; wv.x = v0.x; wv.y = v0.y; wv.z = v1.x; wv.w = v1.y; acc = mfma16(__builtin_bit_cast(bf16x8, wv), pf[0], acc); }
        { const u32x2 v0 = *(const LAS u32x2*)(vl + 32), v1 = *(const LAS u32x2*)(vl + 48); u32x4 wv; wv.x = v0.x; wv.y = v0.y; wv.z = v1.x; wv.w = v1.y; acc = mfma16(__builtin_bit_cast(bf16x8, wv), pf[1], acc); }
        o[d4] = acc; ss += (acc[0] * acc[0] + acc[1] * acc[1]) + (acc[2] * acc[2] + acc[3] * acc[3]);
    }
    ss += __shfl_xor(ss, 16); ss += __shfl_xor(ss, 32);
    if (g == 0) SS[dvh * 64 + 16 * Iw + n] = ss;
    __syncthreads();
    const float tot = SS[16 * Iw + n] + SS[64 + 16 * Iw + n];
    const float rstd = rsqrtf(tot * (1.0f / 128.0f) + RMS_EPS);
#pragma unroll
    for (int d4 = 0; d4 < 4; ++d4) {
        const int dv = 16 * (4 * dvh + d4) + 4 * g;
        const f32x4 gn = *(const f32x4*)(gnorm + dv);
        const u32x2 hg = hgv[d4];
        u32x2 ov; ov.x = pk2(o[d4][0] * rstd * gn[0] * bflo(hg.x), o[d4][1] * rstd * gn[1] * bfhi(hg.x)); ov.y = pk2(o[d4][2] * rstd * gn[2] * bflo(hg.y), o[d4][3] * rstd * gn[3] * bfhi(hg.y));
        *(u32x2*)(Y + (tok0 + 16 * Iw + n) * DM + 1024 + h * 128 + dv) = ov;
    }
    __syncthreads();
}

#define XB_TMO      128
#define XB_XCNT(j)  (256  + 64 * (j))
#define XB_XSUB(j)  (1280 + 64 * (j))
#define XB_XGEN(j)  (2304 + 64 * (j))
#define XB_TOP      3328
#define XB_TOPGEN   3392
#define XCD_BAR_WORDS 3456
#define XB_SPIN_CAP (1u << 18)
__device__ __forceinline__ unsigned xb_ld(unsigned* p)              { return __hip_atomic_load(p, __ATOMIC_RELAXED, __HIP_MEMORY_SCOPE_AGENT); }
__device__ __forceinline__ unsigned xb_add(unsigned* p, unsigned v) { return __hip_atomic_fetch_add(p, v, __ATOMIC_RELAXED, __HIP_MEMORY_SCOPE_AGENT); }
__device__ __forceinline__ unsigned xb_xcc_id() { return (unsigned)__builtin_amdgcn_s_getreg((3 << 11) | 20) & 0xFu; }
#define XB_SPIN(cond, bar) do { unsigned _sp = 0; while (cond) { __builtin_amdgcn_s_sleep(1); \
    if ((++_sp & 255u) == 0u) { if (xb_ld(&(bar)[XB_TMO])) break; if (_sp > XB_SPIN_CAP) { atomicAdd(&(bar)[XB_TMO], 1u); break; } } } } while (0)
__device__ __forceinline__ void xcd_barrier_complete(unsigned* bar, unsigned x, unsigned& nloc, unsigned& nx) {
    const unsigned G = gridDim.x * gridDim.y * gridDim.z;
    unsigned sum, cnt, mine, sp = 0u;
    for (;;) {
        sum = 0u; cnt = 0u; mine = 0u;
#pragma unroll
        for (unsigned j = 0; j < 16; ++j) { const unsigned c = xb_ld(&bar[XB_XCNT(j)]); sum += c; cnt += (c > 0u) ? 1u : 0u; mine = (j == x) ? c : mine; }
        if (sum == G) break;
        __builtin_amdgcn_s_sleep(1);
        if ((++sp & 255u) == 0u) { if (xb_ld(&bar[XB_TMO])) break; if (sp > XB_SPIN_CAP) { atomicAdd(&bar[XB_TMO], 1u); break; } }
    }
    nloc = mine > 0u ? mine : 1u; nx = cnt > 0u ? cnt : 1u;
}
__device__ __forceinline__ void xcd_barrier(unsigned* bar, volatile LAS unsigned* st, bool tid0) {
    asm volatile("s_waitcnt vmcnt(0)" ::: "memory");
    __syncthreads();
    if (tid0) {
        const unsigned x = xb_xcc_id();
        __builtin_amdgcn_s_waitcnt(0);
        unsigned nloc = st[0], nx = st[1];
        if (nloc == 0u) { xcd_barrier_complete(bar, x, nloc, nx); st[0] = nloc; st[1] = nx; }
        const unsigned old = xb_add(&bar[XB_XSUB(x)], 1u);
        const unsigned gen = old / nloc;
        if (old + 1u == (gen + 1u) * nloc) {
            __builtin_amdgcn_fence(__ATOMIC_RELEASE, "agent");
            asm volatile("s_waitcnt vmcnt(0)" ::: "memory");
            const unsigned og = xb_add(&bar[XB_TOP], 1u);
            const unsigned tg = og / nx;
            if (og + 1u == (tg + 1u) * nx) xb_add(&bar[XB_TOPGEN], 1u);
            else XB_SPIN(xb_ld(&bar[XB_TOPGEN]) == tg, bar);
            __builtin_amdgcn_fence(__ATOMIC_ACQUIRE, "agent");
            xb_add(&bar[XB_XGEN(x)], 1u);
            asm volatile("s_waitcnt vmcnt(0)" ::: "memory");
        } else {
            XB_SPIN(xb_ld(&bar[XB_XGEN(x)]) == gen, bar);
            __builtin_amdgcn_fence(__ATOMIC_ACQUIRE, "agent");
            asm volatile("s_waitcnt vmcnt(0)" ::: "memory");
        }
    }
    __syncthreads();
}

__device__ __forceinline__ void counter_barrier(unsigned* cnt, unsigned target, bool tid0) {
    __builtin_amdgcn_fence(__ATOMIC_RELEASE, "agent");
    asm volatile("s_waitcnt vmcnt(0)" ::: "memory");
    __syncthreads();
    if (tid0) {
        __hip_atomic_fetch_add(cnt, 1u, __ATOMIC_RELAXED, __HIP_MEMORY_SCOPE_AGENT);
        while (__hip_atomic_load(cnt, __ATOMIC_RELAXED, __HIP_MEMORY_SCOPE_AGENT) < target) __builtin_amdgcn_s_sleep(2);
    }
    __syncthreads();
    __builtin_amdgcn_fence(__ATOMIC_ACQUIRE, "agent");
    asm volatile("s_waitcnt vmcnt(0)" ::: "memory");
}

#ifndef PHASE_MASK
#define PHASE_MASK 0xFFFFF
#endif
#ifndef REP_MASK
#define REP_MASK 0
#endif
#define PH(k) if constexpr ((PHASE_MASK >> (k)) & 1) _Pragma("nounroll") for (int rep_ = 0; rep_ < ((((REP_MASK) >> (k)) & 1) ? 2 : 1); ++rep_)
constexpr int IT_IN = 32 * 304, IT_GU = 32 * 352, IT_DN = 88 * 64, IT_SQ = 32 * 64, IT_BR = 16 * 64, IT_PP = 4 * 64;
constexpr int IT_REST = IT_DN + 2 * IT_SQ + 2 * IT_BR + IT_PP;
struct Args { const float* in[20]; float* out; unsigned char* ws; };
enum { I_X = 0, I_P, I_POS, I_GMIXPRE, I_WIN, I_SINKS, I_LBL, I_GNORM, I_WATT, I_WHGRN, I_WOUT, I_GMIXPOST, I_GFFNPRE, I_WGU, I_WDN, I_GFFNPOST, I_GPLEPRE, I_WPG, I_WPP, I_GPLEPOST };

__device__ __forceinline__ int my_lane_() { int l; asm volatile("v_mbcnt_lo_u32_b32 %0, -1, 0\n\tv_mbcnt_hi_u32_b32 %0, -1, %0" : "=v"(l)); return l; }
__device__ __forceinline__ void* ldptr(LAS unsigned long long* PT, int k) {
    const unsigned long long v = PT[k];
    const unsigned lo = __builtin_amdgcn_readfirstlane((unsigned)v), hi = __builtin_amdgcn_readfirstlane((unsigned)(v >> 32));
    return (void*)(__attribute__((address_space(1))) void*)(((unsigned long long)hi << 32) | lo);
}
__global__ void __launch_bounds__(512, 2) fwd_megakernel(Args a) {
    extern __shared__ __attribute__((aligned(16))) unsigned char lds_raw[];
    LAS unsigned char* lds = (LAS unsigned char*)lds_raw;
    cg::grid_group grid = cg::this_grid();
    const int G = gridDim.x, bid = blockIdx.x, ngw = G * 8;
    const int wave_s = __builtin_amdgcn_readfirstlane((int)threadIdx.x >> 6);
#define MYLANE my_lane_()
#define MYTID (wave_s * 64 + MYLANE)
#define PH_IDS int tid_l = MYTID; asm volatile("" : "+v"(tid_l)); const int tid = tid_l, lane = tid & 63, wave = __builtin_amdgcn_readfirstlane(tid >> 6), gw = bid * 8 + wave; (void)lane; (void)gw;
    LAS unsigned long long* PT = (LAS unsigned long long*)(lds + 146432 + 64);
    volatile LAS unsigned* XST = (volatile LAS unsigned*)(lds + 146432);
    if (threadIdx.x == 0) {
#pragma unroll
        for (int i = 0; i < 20; ++i) PT[i] = (unsigned long long)a.in[i];
        PT[20] = (unsigned long long)a.out; PT[21] = (unsigned long long)a.ws;
        XST[0] = 0u; XST[1] = 0u;
        (void)xb_add((unsigned*)a.ws + XB_XCNT(xb_xcc_id()), 1u);
    }
    __syncthreads();
#define GSYNC xcd_barrier((unsigned*)ws, XST, MYTID == 0)
#define LDP(k) ldptr(PT, (k))
#define INF(k) ((const float*)LDP(k))
#define OUTP ((float*)LDP(20))
    unsigned char* ws = (unsigned char*)LDP(21);
#define WIN ((bf16_t*)(ws + WS_WIN))
#define WMRG ((bf16_t*)(ws + WS_WMRG))
#define WOUT ((bf16_t*)(ws + WS_WOUT))
#define WGU ((bf16_t*)(ws + WS_WGU))
#define WDN ((bf16_t*)(ws + WS_WDN))
#define WPG ((bf16_t*)(ws + WS_WPG))
#define WPP ((bf16_t*)(ws + WS_WPP))
#define HB ((bf16_t*)(ws + WS_HB))
#define PB ((bf16_t*)(ws + WS_PB))
#define ROPE ((float*)(ws + WS_ROPE))
#define LB ((float*)(ws + WS_LB))
#define DC ((float*)(ws + WS_DC))
#define PART ((float*)(ws + WS_PART))
#define Qb ((bf16_t*)(ws + WS_Q))
#define Kb ((bf16_t*)(ws + WS_K))
#define VT ((bf16_t*)(ws + WS_VT))
#define HQ ((bf16_t*)(ws + WS_HQ))
#define HZ ((bf16_t*)(ws + WS_HZ))
#define HVT ((bf16_t*)(ws + WS_HVT))
#define HG ((bf16_t*)(ws + WS_HG))
#define GSA ((bf16_t*)(ws + WS_GSA))
#define GSB ((bf16_t*)(ws + WS_GSB))
#define STb ((bf16_t*)(ws + WS_ST))
#define MRG ((bf16_t*)(ws + WS_MRG))
#define ACT ((bf16_t*)(ws + WS_ACT))
#define Y1 ((bf16_t*)(ws + WS_Y1))
#define Y2 ((bf16_t*)(ws + WS_Y2))
#define E0 ((bf16_t*)(ws + WS_E0))
#define EB ((bf16_t*)(ws + WS_E))
#define U ((bf16_t*)OUTP)

    PH(0) { PH_IDS
        LAS float* scr = (LAS float*)(lds + wave * 16384);
        for (int it = gw; it < IT_IN + IT_GU; it += ngw) {
            int r = it;
            if (r < IT_IN) { const int kb = r / 304, nb = r % 304, n0 = 32 * nb; int dr = n0;
                if (n0 < 1280) { const int pn = n0 >> 8, c = n0 & 255, head = c >> 6, hf = (c & 63) >> 5; dr = pn * 256 + 128 * hf + head * 32; }
                else if (n0 >= 5632) { const int isb = n0 >= 7680, jj = isb ? n0 - 7680 : n0 - 5632; dr = 5632 + (jj >> 7) * 256 + 128 * isb + (jj & 127); }
                transpose_item(INF(I_WIN), INW, WIN, 2048, dr, 64 * kb, 64 * kb, n0, scr, lane); continue; } r -= IT_IN;
            { const int kb = r / 352, nb = r % 352, n0 = 32 * nb; const int up = n0 >= DFF, j = up ? n0 - DFF : n0; const int dr = (j >> 7) * 256 + 128 * up + (j & 127);
                transpose_item(INF(I_WGU), NGU, WGU, 2048, dr, 64 * kb, 64 * kb, n0, scr, lane); }
        }
        for (int m = gw; m < T; m += ngw) rms_row_to_bf16(INF(I_X) + (size_t)m * DM, INF(I_GMIXPRE), HB + (size_t)m * DM, lane);
        const int gt = bid * 512 + tid, ngt = G * 512;
        const int* pos = (const int*)INF(I_POS);
        for (int i = gt; i < T * 32; i += ngt) { const int t = i >> 5, d = i & 31;
            const float invf = powf(10000.0f, -(float)d * (1.0f / 32.0f)); const float ang = (float)pos[t] * invf;
            const double rev = (double)ang * 0.15915494309189535; const float fr = (float)(rev - rint(rev));
            ROPE[(size_t)t * 64 + d] = __builtin_amdgcn_cosf(fr); ROPE[(size_t)t * 64 + 32 + d] = __builtin_amdgcn_sinf(fr); }
        for (int i = gt; i < 1024; i += ngt) { const float l0 = INF(I_LBL)[i], l1 = INF(I_LBL)[1024 + i]; LB[i] = 1.0f / (1.0f + expf(l1 - l0)); }
    }
    GSYNC;
    if (G > (1 << 20)) grid.sync();

    PH(1) {
        pg8::Gemm g{HB, WIN, 2048, 32}; pg8::StaticOrder S; S.init(T, INW, G, bid);
        pg8::EpiProj E{ws};
        pg8::gemm_phase(lds, g, S, E, MYTID);
        const int rem = ((T / 256) * (INW / 256)) % G;
        if (rem == 0 || bid >= rem) { PH_IDS (void)gw;
            LAS float* scr = (LAS float*)(lds + wave * 16384);
            const int first = (rem == 0 ? bid : bid - rem) * 8 + wave, step = (rem == 0 ? G : G - rem) * 8;
            {
                const int gt2 = (rem == 0 ? bid : bid - rem) * 512 + tid, ngt2 = (rem == 0 ? G : G - rem) * 512;
                for (int i = gt2; i < T * 64; i += ngt2) { const f32x4 v = ((const f32x4*)INF(I_P))[i]; u32x2 w; w.x = pk2(v[0], v[1]); w.y = pk2(v[2], v[3]); ((u32x2*)PB)[i] = w; }
            }
            for (int it = first; it < IT_REST; it += step) {
                int r = it;
                if (r < IT_DN) { const int kb = r / 64, nb = r % 64; transpose_item(INF(I_WDN), DM, WDN, DFF, 32 * nb, 64 * kb, 64 * kb, 32 * nb, scr, lane); continue; } r -= IT_DN;
                if (r < IT_SQ) { const int kb = r / 64, nb = r % 64; transpose_item(INF(I_WOUT), DM, WOUT, 2048, 32 * nb, 64 * kb, 64 * kb, 32 * nb, scr, lane); continue; } r -= IT_SQ;
                if (r < IT_SQ) { const int kb = r / 64, nb = r % 64; transpose_item(INF(I_WPG), DM, WPG, 2048, 32 * nb, 64 * kb, 64 * kb, 32 * nb, scr, lane); continue; } r -= IT_SQ;
                if (r < IT_BR) { const int kb = r / 64, nb = r % 64; transpose_item(INF(I_WATT), DM, WMRG, 2048, 32 * nb, 64 * kb, 64 * kb, 32 * nb, scr, lane); continue; } r -= IT_BR;
                if (r < IT_BR) { const int kb = r / 64, nb = r % 64; transpose_item(INF(I_WHGRN), DM, WMRG, 2048, 32 * nb, 1024 + 64 * kb, 64 * kb, 32 * nb, scr, lane); continue; } r -= IT_BR;
                { const int kb = r / 64, nb = r % 64; transpose_item(INF(I_WPP), DM, WPP, 256, 32 * nb, 64 * kb, 64 * kb, 32 * nb, scr, lane); }
            }
        }
    }
    GSYNC;

    PH(2) {
        { PH_IDS (void)wave; attn_units(lds, Qb, Kb, VT, INF(I_SINKS), HB, bid, G, tid); }
        { PH_IDS (void)wave; hgrn_passA_units(lds, HZ, HVT, LB, U, DC, bid, G, tid); }
    }
    GSYNC;

    PH(3) { PH_IDS
        const int gt = bid * 512 + tid, ngt = G * 512;
        for (int item = gt; item < 16 * 128 * 64; item += ngt) {
            const int kp = item & 63, dv = (item >> 6) & 127, bh = item >> 13;
            f32x2 s = {0.f, 0.f};
            const unsigned* up = (const unsigned*)(U + (size_t)bh * 128 * 16384 + (size_t)dv * 128) + kp;
            const f32x2* dp = (const f32x2*)(DC + (size_t)bh * 128 * 128) + kp;
            unsigned* sp = (unsigned*)(STb + (size_t)bh * 128 * 16384 + (size_t)dv * 128) + kp;
#pragma unroll 8
            for (int c = 0; c < 128; ++c) {
                sp[(size_t)c * 8192] = pk2(s[0], s[1]);
                const unsigned ub = up[(size_t)c * 8192]; const f32x2 u = {bflo(ub), bfhi(ub)}, d = dp[(size_t)c * 64];
                s = d * s + u;
            }
        }
    }
    GSYNC;

    PH(4) { PH_IDS
        bf16_t* YC = HB;
        for (int it = bid; it < 2048; it += G) { const int h = it & 7, c = (it >> 3) & 127, b = it >> 10;
            hgrn_passC(lds, HQ, HZ, HVT, HG, LB, STb, INF(I_GNORM), YC, b, c, h, tid); }
    }
    GSYNC;

    PH(5) {
        pg8::Gemm g{HB, WMRG, 2048, 16}; pg8::SplitKOrder S; S.b.init(T, DM, G, bid); S.kbytes = 1024 * 2;
        pg8::EpiMerged E{GSA, GSB, MRG};
        pg8::gemm_phase(lds, g, S, E, MYTID);
    }
    GSYNC;

    PH(6) {
        pg8::Gemm g{MRG, WOUT, 2048, 32}; pg8::StaticOrder S; S.init(T, DM, G, bid);
        pg8::EpiRowSSb E{Y1, PART};
        pg8::gemm_phase(lds, g, S, E, MYTID);
    }
    GSYNC;

    PH(7) { PH_IDS rowpass<false, true>(Y1, PART, INF(I_X), OUTP, INF(I_GMIXPOST), INF(I_GFFNPRE), HB, gw, ngw, lane); }
    GSYNC;

    PH(8) {
        pg8::Gemm g{HB, WGU, 2048, 32}; pg8::StaticOrder S; S.init(T, NGU, G, bid);
        pg8::EpiSwiglu E{ACT};
        pg8::gemm_phase(lds, g, S, E, MYTID);
    }
    GSYNC;

    PH(9) {
        pg8::Gemm g{ACT, WDN, DFF, DFF / 64}; pg8::StaticOrder S; S.init(T, DM, G, bid);
        pg8::EpiRowSSb E{Y2, PART};
        pg8::gemm_phase(lds, g, S, E, MYTID);
    }
    GSYNC;

    PH(10) { PH_IDS rowpass<true, true>(Y2, PART, OUTP, (void*)(ws + WS_X2), INF(I_GFFNPOST), INF(I_GPLEPRE), HB, gw, ngw, lane); }
    GSYNC;

    PH(11) {
        pg8::Gemm g{PB, WPP, 256, 4}; pg8::StaticOrder S; S.init(T, DM, G, bid);
        pg8::EpiE0 E{E0};
        pg8::gemm_phase(lds, g, S, E, MYTID);
    }
    __builtin_amdgcn_sched_barrier(0);
    PH(12) {
        pg8::Gemm g{HB, WPG, 2048, 32}; pg8::StaticOrder S; S.init(T, DM, G, bid);
        pg8::EpiPle E{E0, EB, PART};
        pg8::gemm_phase(lds, g, S, E, MYTID);
    }
    GSYNC;

    PH(13) { PH_IDS rowpass<true, false>(EB, PART, (const void*)(ws + WS_X2), OUTP, INF(I_GPLEPOST), nullptr, nullptr, gw, ngw, lane); }
}

extern "C" void kernel_launch(void* const* d_in, const int* in_sizes, int n_in, void* d_out, int out_size, void* d_ws, size_t ws_size, hipStream_t stream) {
    static int grid = 0;
    if (grid == 0) {
        if (n_in != 20 || out_size != T * DM || ws_size < WS_END) { fprintf(stderr, "kernel_launch: unexpected shapes (n_in %d out %d ws %zu)\n", n_in, out_size, ws_size); grid = -1; return; }
        int dev = 0, cus = 0, per_cu = 0;
        hipGetDevice(&dev); hipDeviceGetAttribute(&cus, hipDeviceAttributeMultiprocessorCount, dev);
        if (hipFuncSetAttribute((const void*)fwd_megakernel, hipFuncAttributeMaxDynamicSharedMemorySize, LDS_BYTES) != hipSuccess) { fprintf(stderr, "kernel_launch: hipFuncSetAttribute failed\n"); grid = -1; return; }
        if (hipOccupancyMaxActiveBlocksPerMultiprocessor(&per_cu, (const void*)fwd_megakernel, 512, LDS_BYTES) != hipSuccess || per_cu < 1) { fprintf(stderr, "kernel_launch: occupancy query gave %d\n", per_cu); per_cu = 1; }
        (void)hipGetLastError();
        grid = cus * 1;
        fprintf(stderr, "kernel_launch: grid %d (cus %d, per_cu %d)\n", grid, cus, per_cu);
    }
    if (grid < 0) return;
    if (hipMemsetAsync(d_ws, 0, 16384, stream) != hipSuccess) { fprintf(stderr, "kernel_launch: memset failed\n"); return; }
    Args a{};
    for (int i = 0; i < 20; ++i) a.in[i] = (const float*)d_in[i];
    a.out = (float*)d_out; a.ws = (unsigned char*)d_ws;
    void* args[] = {&a};
    hipError_t e = hipLaunchCooperativeKernel((const void*)fwd_megakernel, dim3(grid), dim3(512), args, LDS_BYTES, stream);
    if (e != hipSuccess) fprintf(stderr, "kernel_launch: cooperative launch failed: %s\n", hipGetErrorString(e));
}
```

```cpp
#include <hip/hip_runtime.h>
#include <hip/hip_cooperative_groups.h>
#include <cstdio>
#include <cstdint>
namespace cg = cooperative_groups;

#define LAS __attribute__((address_space(3)))
typedef unsigned short bf16_t;
typedef short bf16x8 __attribute__((ext_vector_type(8)));
typedef short bf16x4 __attribute__((ext_vector_type(4)));
typedef float f32x4 __attribute__((ext_vector_type(4)));
typedef float f32x2 __attribute__((ext_vector_type(2)));
typedef unsigned u32x4 __attribute__((ext_vector_type(4)));
typedef unsigned u32x2 __attribute__((ext_vector_type(2)));

constexpr int T = 16384, SEQ = 8192, DM = 2048, INW = 9728, DFF = 5632, NGU = 11264;
constexpr float RMS_EPS = 1e-6f;
constexpr size_t MiB = 1u << 20;
constexpr size_t WS_LB = 65536;
constexpr size_t WS_WMRG = 1 * MiB, WS_WOUT = 9 * MiB, WS_WGU = 17 * MiB, WS_WDN = 61 * MiB, WS_WPG = 83 * MiB, WS_WPP = 91 * MiB;
constexpr size_t WS_HB = 92 * MiB;
constexpr size_t WS_PB = 156 * MiB;
constexpr size_t WS_ROPE = 164 * MiB;
constexpr size_t WS_DC = 164 * MiB;
constexpr size_t WS_PART = 166 * MiB;
constexpr size_t WS_BIG = 168 * MiB;
constexpr size_t WS_WIN = WS_BIG, WS_Q = 206 * MiB, WS_K = 238 * MiB, WS_VT = 246 * MiB, WS_HQ = 254 * MiB, WS_HZ = 286 * MiB, WS_HVT = 318 * MiB,
                 WS_HG = 350 * MiB, WS_GSA = 382 * MiB, WS_GSB = 446 * MiB, WS_END = 510 * MiB;
constexpr size_t WS_ST = WS_BIG;
constexpr size_t WS_MRG = WS_HQ;
constexpr size_t WS_ACT = 334 * MiB;
constexpr size_t WS_Y1 = WS_BIG;
constexpr size_t WS_Y2 = WS_BIG;
constexpr size_t WS_E0 = 334 * MiB;
constexpr size_t WS_E = WS_BIG;
constexpr size_t WS_X2 = 398 * MiB;
constexpr int LDS_BYTES = 147456;

typedef float f32x2_t_ __attribute__((ext_vector_type(2)));
typedef __bf16 bf16x2_t_ __attribute__((ext_vector_type(2)));
__device__ __forceinline__ unsigned cvtpk_(float lo, float hi) { const f32x2_t_ v = {lo, hi}; const bf16x2_t_ b = __builtin_convertvector(v, bf16x2_t_); return __builtin_bit_cast(unsigned, b); }
__device__ __forceinline__ unsigned f2bf(float f) { return cvtpk_(f, f) & 0xffffu; }
__device__ __forceinline__ float bf2f(unsigned h) { return __builtin_bit_cast(float, h << 16); }
__device__ __forceinline__ unsigned pk2(float lo, float hi) { return cvtpk_(lo, hi); }
__device__ __forceinline__ unsigned f2bf_sw(float f) { unsigned u = __builtin_bit_cast(unsigned, f); return (u + 0x7fffu + ((u >> 16) & 1u)) >> 16; }
__device__ __forceinline__ unsigned pk2_sw(float lo, float hi) { return f2bf_sw(lo) | (f2bf_sw(hi) << 16); }
__device__ __forceinline__ float bflo(unsigned w) { return __builtin_bit_cast(float, w << 16); }
__device__ __forceinline__ float bfhi(unsigned w) { return __builtin_bit_cast(float, w & 0xffff0000u); }
__device__ __forceinline__ float wave_sum(float v) {
#pragma unroll
    for (int o = 1; o < 64; o <<= 1) v += __shfl_xor(v, o);
    return v;
}
__device__ __forceinline__ float sigmoidf_(float x) { return __builtin_amdgcn_rcpf(1.0f + __expf(-x)); }
__device__ __forceinline__ f32x4 mfma16(bf16x8 a, bf16x8 b, f32x4 c) { return __builtin_amdgcn_mfma_f32_16x16x32_bf16(a, b, c, 0, 0, 0); }

namespace pg8 {
constexpr int BM = 256, BK = 64, HALF = 128, HTB = HALF * BK * 2, NXCD = 8, WGM = 4;
__host__ __device__ __forceinline__ int lds_byte(int r, int c) { const int st = (r >> 4) * 2 + (c >> 5), rr = r & 15, cc = c & 31, ob = rr * 64 + cc * 2; return st * 1024 + (ob ^ (((ob >> 9) & 1) << 5)); }
__host__ __device__ __forceinline__ void stage_rc(int b, int& R, int& C) { const int st = b / 1024, sb = b % 1024, swz = sb ^ (((sb >> 9) & 1) << 5); R = (st >> 1) * 16 + swz / 64; C = (st & 1) * 32 + (swz % 64) / 2; }
__host__ __device__ __forceinline__ int perm32(int rho) { const int n = rho >> 4, i = rho & 15; return 8 * (i >> 2) + 4 * n + (i & 3); }

struct Unit { int pm, pn, koff, half; };
struct Gemm { const bf16_t* A; const bf16_t* Bt; int ld; int nt; };

struct StaticOrder {
    int nM, nN, nwg, G, c;
    __device__ void init(int M, int N, int G_, int c_) { nM = M / BM; nN = N / BM; nwg = nM * nN; G = G_; c = c_; }
    __device__ bool next(int i, Unit& u) const {
        const long L = (long)i * G + c; if (L >= nwg) return false;
        int wgid = (int)L; { const int q = nwg / NXCD, r = nwg % NXCD, xcd = wgid % NXCD, off = wgid / NXCD; wgid = (xcd < r ? xcd * (q + 1) : r * (q + 1) + (xcd - r) * q) + off; }
        const int nig = WGM * nN, gid = wgid / nig, fm = gid * WGM, gsz = (nM - fm) < WGM ? (nM - fm) : WGM;
        u.pm = fm + ((wgid % nig) % gsz); u.pn = (wgid % nig) / gsz; u.koff = 0; u.half = 0; return true;
    }
};
struct SplitKOrder {
    StaticOrder b; int kbytes;
    __device__ bool next(int i, Unit& u) const { if (!b.next(i >> 1, u)) return false; u.half = i & 1; u.koff = (i & 1) * kbytes; return true; }
};

__device__ __forceinline__ unsigned cvt_pk_bf16(float lo, float hi) { unsigned r; asm volatile("v_cvt_pk_bf16_f32 %0, %1, %2" : "=v"(r) : "v"(lo), "v"(hi)); return r; }
__device__ __forceinline__ u32x4 pack8(f32x4 a, f32x4 b) { u32x4 w; w.x = cvt_pk_bf16(a[0], a[1]); w.y = cvt_pk_bf16(a[2], a[3]); w.z = cvt_pk_bf16(b[0], b[1]); w.w = cvt_pk_bf16(b[2], b[3]); return w; }

template <class Epi, class Sched>
__device__ __forceinline__ void gemm_phase(LAS unsigned char* lds, const Gemm g, const Sched& S, const Epi& E, int tid_in) {
    int tid_ = tid_in; asm volatile("" : "+v"(tid_));
    const int tid = tid_, wid = __builtin_amdgcn_readfirstlane(tid >> 6), lane = tid & 63, wr = wid >> 2, wc = wid & 3, fr = lane & 15, fq = lane >> 4;
    const int K = g.ld, nt = g.nt;
    unsigned voffA[2], voffB[2];
#pragma unroll
    for (int i = 0; i < 2; ++i) { int R, C; stage_rc(tid * 16 + i * 8192, R, C); const int Rb = (R & ~31) + perm32(R & 31);
        voffA[i] = (unsigned)(R * K + C) * 2u; voffB[i] = (unsigned)(Rb * K + C) * 2u; }
    const size_t kstep = (size_t)(BK * 2);
    const size_t hstep = (size_t)HALF * K * 2;
    const size_t tstep = 2 * hstep;
    const unsigned ldsw = (unsigned)wid * 1024u;
    const int aoff = lds_byte(wr * 64 + fr, fq * 8), boff = lds_byte(wc * 32 + fr, fq * 8);
#define PG8_SA(b, h) (((b) * 2 + (h)) * HTB)
#define PG8_SB(b, h) ((4 + (b) * 2 + (h)) * HTB)
#define PG8_STAGE(bufoff, gbase, voff) do { _Pragma("unroll") for (int _i = 0; _i < 2; ++_i) \
        __builtin_amdgcn_global_load_lds((const unsigned*)((const char*)(gbase) + (voff)[_i]), (LAS unsigned*)(lds + (bufoff) + ldsw + _i * 8192), 16, 0, 0); } while (0)
#define PG8_LDA(dst, b, h) do { _Pragma("unroll") for (int m = 0; m < 4; ++m) _Pragma("unroll") for (int k = 0; k < 2; ++k) dst[m][k] = *(const LAS bf16x8*)(lds + PG8_SA(b, h) + aoff + m * 2048 + k * 1024); } while (0)
#define PG8_LDB(dst, b, h) do { _Pragma("unroll") for (int n = 0; n < 2; ++n) _Pragma("unroll") for (int k = 0; k < 2; ++k) dst[n][k] = *(const LAS bf16x8*)(lds + PG8_SB(b, h) + boff + n * 2048 + k * 1024); } while (0)
#define PG8_MMA(ai, bj, At, Bt) do { __builtin_amdgcn_s_setprio(1); _Pragma("unroll") for (int m = 0; m < 4; ++m) _Pragma("unroll") for (int n = 0; n < 2; ++n) _Pragma("unroll") for (int k = 0; k < 2; ++k) \
        acc[ai][bj][m][n] = __builtin_amdgcn_mfma_f32_16x16x32_bf16(Bt[n][k], At[m][k], acc[ai][bj][m][n], 0, 0, 0); __builtin_amdgcn_s_setprio(0); } while (0)
#define PG8_WAIT_V(n) asm volatile("s_waitcnt vmcnt(" #n ")" ::: "memory")
#define PG8_WAIT_L(n) asm volatile("s_waitcnt lgkmcnt(" #n ")" ::: "memory")
#define PG8_BAR __builtin_amdgcn_s_barrier()
#define PG8_SCHED __builtin_amdgcn_sched_barrier(0)
    Unit cur, nxt; int ui = 0;
    if (!S.next(0, cur)) return;
    f32x4 acc[2][2][4][2];
#pragma unroll
    for (int a = 0; a < 2; ++a)
#pragma unroll
        for (int b = 0; b < 2; ++b)
#pragma unroll
            for (int m = 0; m < 4; ++m)
#pragma unroll
                for (int n = 0; n < 2; ++n) acc[a][b][m][n] = (f32x4){0.f, 0.f, 0.f, 0.f};
    bf16x8 At[4][2], B0[2][2], B1[2][2];
    const char* cA = (const char*)g.A + (size_t)cur.pm * tstep + cur.koff; const char* cB = (const char*)g.Bt + (size_t)cur.pn * tstep + cur.koff;
    PG8_STAGE(PG8_SB(0, 0), cB, voffB); PG8_STAGE(PG8_SB(0, 1), cB + hstep, voffB); PG8_STAGE(PG8_SA(0, 0), cA, voffA); PG8_STAGE(PG8_SA(0, 1), cA + hstep, voffA);
    if (wr == 1) PG8_BAR;
    PG8_WAIT_V(2); PG8_BAR;
    PG8_STAGE(PG8_SB(1, 0), cB + kstep, voffB); PG8_STAGE(PG8_SB(1, 1), cB + hstep + kstep, voffB);
    PG8_WAIT_V(4); PG8_BAR;
    for (;;) {
        const bool has_next = S.next(ui + 1, nxt);
        const char* nA = has_next ? (const char*)g.A + (size_t)nxt.pm * tstep + nxt.koff : cA; const char* nB = has_next ? (const char*)g.Bt + (size_t)nxt.pn * tstep + nxt.koff : cB;
        for (int t = 0; t < nt; t += 2) {
            const bool last = (t == nt - 2);
            const char* a1 = cA + (size_t)(t + 1) * kstep;
            const char* a2 = last ? nA : cA + (size_t)(t + 2) * kstep; const char* b2 = last ? nB : cB + (size_t)(t + 2) * kstep;
            const char* a3 = a2 + kstep; const char* b3 = b2 + kstep;
            PG8_LDB(B0, 0, 0); PG8_LDB(B1, 0, 1); PG8_SCHED; PG8_LDA(At, 0, 0); PG8_STAGE(PG8_SA(1, 0), a1, voffA); PG8_STAGE(PG8_SA(1, 1), a1 + hstep, voffA);
            PG8_WAIT_V(8); PG8_WAIT_L(0); PG8_BAR; PG8_MMA(0, 0, At, B0); PG8_MMA(0, 1, At, B1); PG8_BAR; PG8_SCHED;
            PG8_LDA(At, 0, 1); PG8_STAGE(PG8_SB(0, 0), b2, voffB); PG8_STAGE(PG8_SB(0, 1), b2 + hstep, voffB);
            PG8_WAIT_V(6); PG8_WAIT_L(0); PG8_BAR; PG8_MMA(1, 0, At, B0); PG8_MMA(1, 1, At, B1); PG8_BAR; PG8_SCHED;
            PG8_LDB(B0, 1, 0); PG8_LDB(B1, 1, 1); PG8_SCHED; PG8_LDA(At, 1, 0); PG8_STAGE(PG8_SA(0, 0), a2, voffA); PG8_STAGE(PG8_SA(0, 1), a2 + hstep, voffA);
            PG8_WAIT_V(8); PG8_WAIT_L(0); PG8_BAR; PG8_MMA(0, 0, At, B0); PG8_MMA(0, 1, At, B1); PG8_BAR; PG8_SCHED;
            PG8_LDA(At, 1, 1); PG8_STAGE(PG8_SB(1, 0), b3, voffB); PG8_STAGE(PG8_SB(1, 1), b3 + hstep, voffB);
            PG8_WAIT_V(6); PG8_WAIT_L(0); PG8_BAR; PG8_MMA(1, 0, At, B0); PG8_MMA(1, 1, At, B1); PG8_BAR; PG8_SCHED;
        }
        if (wr == 0) PG8_BAR;
        const bool keep = E(acc, cur, wr, wc, fr, fq);
        if (!has_next) break;
        if (!keep) {
#pragma unroll
            for (int a = 0; a < 2; ++a)
#pragma unroll
                for (int b = 0; b < 2; ++b)
#pragma unroll
                    for (int m = 0; m < 4; ++m)
#pragma unroll
                        for (int n = 0; n < 2; ++n) acc[a][b][m][n] = (f32x4){0.f, 0.f, 0.f, 0.f};
        }
        cur = nxt; cA = nA; cB = nB; ++ui;
        if (wr == 1) PG8_BAR;
    }
    PG8_WAIT_V(0);
    PG8_BAR;
#undef PG8_SA
#undef PG8_SB
#undef PG8_STAGE
#undef PG8_LDA
#undef PG8_LDB
#undef PG8_MMA
#undef PG8_WAIT_V
#undef PG8_WAIT_L
#undef PG8_BAR
#undef PG8_SCHED
}

struct EpiProj {
    unsigned char* ws;
    __device__ __forceinline__ bool operator()(f32x4 (&acc)[2][2][4][2], const Unit& u, int wr, int wc, int fr, int fq) const {
        const int pn = u.pn; const int row0 = u.pm * BM + wr * 64 + fr;
        if (pn < 5) {
            const float* rope = (const float*)(ws + WS_ROPE);
            const bool isq = pn < 4;
            bf16_t* O = (bf16_t*)(ws + (isq ? WS_Q : WS_K)); const int ldo = isq ? 1024 : 256, hcol = isq ? (pn * 4 + wc) * 64 : wc * 64; const float sc = isq ? 0.125f : 1.0f;
#pragma unroll
            for (int ai = 0; ai < 2; ++ai) {
                f32x4 tb[4][4];
#pragma unroll
                for (int m = 0; m < 4; ++m) { const f32x4* rp = (const f32x4*)(rope + (size_t)(row0 + ai * HALF + m * 16) * 64 + 8 * fq); tb[m][0] = rp[0]; tb[m][1] = rp[1]; tb[m][2] = rp[8]; tb[m][3] = rp[9]; }
#pragma unroll
                for (int m = 0; m < 4; ++m) {
                    const int row = row0 + ai * HALF + m * 16;
                    const f32x4 c0 = tb[m][0], c1 = tb[m][1], s0 = tb[m][2], s1 = tb[m][3];
                    const f32x4 x1a = acc[ai][0][m][0], x1b = acc[ai][0][m][1], x2a = acc[ai][1][m][0], x2b = acc[ai][1][m][1];
                    const f32x4 o1a = (x1a * c0 - x2a * s0) * sc, o1b = (x1b * c1 - x2b * s1) * sc;
                    const f32x4 o2a = (x2a * c0 + x1a * s0) * sc, o2b = (x2b * c1 + x1b * s1) * sc;
                    bf16_t* op = O + (size_t)row * ldo + hcol + 8 * fq;
                    *(u32x4*)op = pack8(o1a, o1b); *(u32x4*)(op + 32) = pack8(o2a, o2b);
                }
            }
        } else if (pn == 5 || (pn >= 14 && pn < 18)) {
            bf16_t* O = (bf16_t*)(ws + ((pn == 5) ? WS_VT : WS_HVT + (size_t)(pn - 14) * 256 * T * 2));
#pragma unroll
            for (int bj = 0; bj < 2; ++bj)
#pragma unroll
                for (int n = 0; n < 2; ++n)
#pragma unroll
                    for (int i = 0; i < 4; ++i) {
                        const int col = bj * HALF + wc * 32 + 8 * fq + 4 * n + i;
                        bf16_t* op = O + (size_t)col * T + row0;
#pragma unroll
                        for (int ai = 0; ai < 2; ++ai)
#pragma unroll
                            for (int m = 0; m < 4; ++m) op[ai * HALF + m * 16] = (bf16_t)f2bf(acc[ai][bj][m][n][i]);
                    }
        } else {
            if (pn >= 22) {
                bf16_t* OR = (bf16_t*)(ws + WS_GSA); bf16_t* OB = (bf16_t*)(ws + WS_GSB);
#pragma unroll
                for (int ai = 0; ai < 2; ++ai)
#pragma unroll
                    for (int m = 0; m < 4; ++m) {
                        const size_t o = (size_t)(row0 + ai * HALF + m * 16) * DM + (pn - 22) * HALF + wc * 32 + 8 * fq;
                        f32x4 r[2], b[2];
#pragma unroll
                        for (int n = 0; n < 2; ++n)
#pragma unroll
                            for (int i = 0; i < 4; ++i) { const float ea = __expf(-acc[ai][0][m][n][i]), eb = __expf(-acc[ai][1][m][n][i]); b[n][i] = __builtin_amdgcn_rcpf(1.0f + eb); r[n][i] = (1.0f + eb) * __builtin_amdgcn_rcpf(1.0f + ea); }
                        *(u32x4*)(OR + o) = pack8(r[0], r[1]); *(u32x4*)(OB + o) = pack8(b[0], b[1]);
                    }
                return false;
            }
            size_t ooff; int ldo, cb; int mode;
            if (pn < 10) { ooff = WS_HQ; ldo = 1024; cb = (pn - 6) * 256; mode = 3; }
            else if (pn < 14) { ooff = WS_HZ; ldo = 1024; cb = (pn - 10) * 256; mode = 0; }
            else if (pn < 22) { ooff = WS_HG; ldo = 1024; cb = (pn - 18) * 256; mode = 2; }
            else if (pn < 30) { ooff = WS_GSA; ldo = 2048; cb = (pn - 22) * 256; mode = 1; }
            else { ooff = WS_GSB; ldo = 2048; cb = (pn - 30) * 256; mode = 1; }
            bf16_t* O = (bf16_t*)(ws + ooff);
            const float osc = (mode == 3) ? 0.08838834764831845f : 1.0f;
#pragma unroll
            for (int ai = 0; ai < 2; ++ai)
#pragma unroll
                for (int m = 0; m < 4; ++m) {
                    bf16_t* rowp = O + (size_t)(row0 + ai * HALF + m * 16) * ldo + cb + wc * 32 + 8 * fq;
#pragma unroll
                    for (int bj = 0; bj < 2; ++bj) {
                        f32x4 v[2] = {acc[ai][bj][m][0], acc[ai][bj][m][1]};
#pragma unroll
                        for (int n = 0; n < 2; ++n)
#pragma unroll
                            for (int i = 0; i < 4; ++i) { const float x = v[n][i]; const float s = sigmoidf_(x); v[n][i] = (mode == 0) ? x : (mode == 1) ? s : x * s * osc; }
                        *(u32x4*)(rowp + bj * HALF) = pack8(v[0], v[1]);
                    }
                }
        }
        return false;
    }
};
struct EpiMerged {
    const bf16_t *GSA, *GSB; bf16_t* O;
    __device__ __forceinline__ bool operator()(f32x4 (&acc)[2][2][4][2], const Unit& u, int wr, int wc, int fr, int fq) const {
        const int row0 = u.pm * BM + wr * 64 + fr, col0 = u.pn * BM + wc * 32 + 8 * fq;
        const bf16_t* G = (u.half == 0) ? GSA : GSB;
#pragma unroll
        for (int ai = 0; ai < 2; ++ai) {
            u32x4 gv[4][2];
#pragma unroll
            for (int m = 0; m < 4; ++m)
#pragma unroll
                for (int bj = 0; bj < 2; ++bj) gv[m][bj] = *(const u32x4*)(G + (size_t)(row0 + ai * HALF + m * 16) * DM + col0 + bj * HALF);
#pragma unroll
            for (int m = 0; m < 4; ++m)
#pragma unroll
                for (int bj = 0; bj < 2; ++bj) {
                    const u32x4 gw = gv[m][bj];
                    const float fg[8] = {bflo(gw.x), bfhi(gw.x), bflo(gw.y), bfhi(gw.y), bflo(gw.z), bfhi(gw.z), bflo(gw.w), bfhi(gw.w)};
#pragma unroll
                    for (int n = 0; n < 2; ++n)
#pragma unroll
                        for (int i = 0; i < 4; ++i) acc[ai][bj][m][n][i] *= fg[4 * n + i];
                    if (u.half != 0) *(u32x4*)(O + (size_t)(row0 + ai * HALF + m * 16) * DM + col0 + bj * HALF) = pack8(acc[ai][bj][m][0], acc[ai][bj][m][1]);
                }
        }
        return u.half == 0;
    }
};
struct EpiRowSS {
    float* Y; float* part;
    __device__ __forceinline__ bool operator()(f32x4 (&acc)[2][2][4][2], const Unit& u, int wr, int wc, int fr, int fq) const {
        const int row0 = u.pm * BM + wr * 64 + fr, col0 = u.pn * BM + wc * 32 + 8 * fq;
#pragma unroll
        for (int ai = 0; ai < 2; ++ai)
#pragma unroll
            for (int m = 0; m < 4; ++m) {
                const int row = row0 + ai * HALF + m * 16; float ss = 0.f;
#pragma unroll
                for (int bj = 0; bj < 2; ++bj) {
                    const f32x4 v0 = acc[ai][bj][m][0], v1 = acc[ai][bj][m][1];
                    float* yp = Y + (size_t)row * DM + col0 + bj * HALF;
                    *(f32x4*)yp = v0; *(f32x4*)(yp + 4) = v1;
                    ss += (v0[0] * v0[0] + v0[1] * v0[1]) + (v0[2] * v0[2] + v0[3] * v0[3]) + (v1[0] * v1[0] + v1[1] * v1[1]) + (v1[2] * v1[2] + v1[3] * v1[3]);
                }
                ss += __shfl_xor(ss, 16); ss += __shfl_xor(ss, 32);
                if (fq == 0) part[(size_t)row * 32 + u.pn * 4 + wc] = ss;
            }
        return false;
    }
};
struct EpiRowSSb {
    bf16_t* Y; float* part;
    __device__ __forceinline__ bool operator()(f32x4 (&acc)[2][2][4][2], const Unit& u, int wr, int wc, int fr, int fq) const {
        const int row0 = u.pm * BM + wr * 64 + fr, col0 = u.pn * BM + wc * 32 + 8 * fq;
#pragma unroll
        for (int ai = 0; ai < 2; ++ai)
#pragma unroll
            for (int m = 0; m < 4; ++m) {
                const int row = row0 + ai * HALF + m * 16; float ss = 0.f;
#pragma unroll
                for (int bj = 0; bj < 2; ++bj) {
                    const f32x4 v0 = acc[ai][bj][m][0], v1 = acc[ai][bj][m][1];
                    *(u32x4*)(Y + (size_t)row * DM + col0 + bj * HALF) = pack8(v0, v1);
                    ss += (v0[0] * v0[0] + v0[1] * v0[1]) + (v0[2] * v0[2] + v0[3] * v0[3]) + (v1[0] * v1[0] + v1[1] * v1[1]) + (v1[2] * v1[2] + v1[3] * v1[3]);
                }
                ss += __shfl_xor(ss, 16); ss += __shfl_xor(ss, 32);
                if (fq == 0) part[(size_t)row * 32 + u.pn * 4 + wc] = ss;
            }
        return false;
    }
};
struct EpiSwiglu {
    bf16_t* O;
    __device__ __forceinline__ bool operator()(f32x4 (&acc)[2][2][4][2], const Unit& u, int wr, int wc, int fr, int fq) const {
        const int row0 = u.pm * BM + wr * 64 + fr, col0 = u.pn * HALF + wc * 32 + 8 * fq;
#pragma unroll
        for (int ai = 0; ai < 2; ++ai)
#pragma unroll
            for (int m = 0; m < 4; ++m) {
                f32x4 v[2];
#pragma unroll
                for (int n = 0; n < 2; ++n)
#pragma unroll
                    for (int i = 0; i < 4; ++i) { const float gx = acc[ai][0][m][n][i]; v[n][i] = gx * sigmoidf_(gx) * acc[ai][1][m][n][i]; }
                *(u32x4*)(O + (size_t)(row0 + ai * HALF + m * 16) * DFF + col0) = pack8(v[0], v[1]);
            }
        return false;
    }
};
struct EpiE0 {
    bf16_t* E0;
    __device__ __forceinline__ bool operator()(f32x4 (&acc)[2][2][4][2], const Unit& u, int wr, int wc, int fr, int fq) const {
        const int row0 = u.pm * BM + wr * 64 + fr, col0 = u.pn * BM + wc * 32 + 8 * fq;
#pragma unroll
        for (int ai = 0; ai < 2; ++ai)
#pragma unroll
            for (int m = 0; m < 4; ++m)
#pragma unroll
                for (int bj = 0; bj < 2; ++bj)
                    *(u32x4*)(E0 + (size_t)(row0 + ai * HALF + m * 16) * DM + col0 + bj * HALF) = pack8(acc[ai][bj][m][0], acc[ai][bj][m][1]);
        return false;
    }
};
struct EpiPle {
    const bf16_t* E0; bf16_t* Y; float* part;
    __device__ __forceinline__ bool operator()(f32x4 (&acc)[2][2][4][2], const Unit& u, int wr, int wc, int fr, int fq) const {
        const int row0 = u.pm * BM + wr * 64 + fr, col0 = u.pn * BM + wc * 32 + 8 * fq;
#pragma unroll
        for (int ai = 0; ai < 2; ++ai)
#pragma unroll
            for (int m = 0; m < 4; ++m) {
                const int row = row0 + ai * HALF + m * 16; float ss = 0.f;
#pragma unroll
                for (int bj = 0; bj < 2; ++bj) {
                    const size_t off = (size_t)row * DM + col0 + bj * HALF;
                    const u32x4 eb = *(const u32x4*)(E0 + off);
                    const float fe[8] = {bflo(eb.x), bfhi(eb.x), bflo(eb.y), bfhi(eb.y), bflo(eb.z), bfhi(eb.z), bflo(eb.w), bfhi(eb.w)};
                    f32x4 v[2];
#pragma unroll
                    for (int n = 0; n < 2; ++n)
#pragma unroll
                        for (int i = 0; i < 4; ++i) { const float e = fe[4 * n + i] * sigmoidf_(acc[ai][bj][m][n][i]); v[n][i] = e; ss += e * e; }
                    *(u32x4*)(Y + off) = pack8(v[0], v[1]);
                }
                ss += __shfl_xor(ss, 16); ss += __shfl_xor(ss, 32);
                if (fq == 0) part[(size_t)row * 32 + u.pn * 4 + wc] = ss;
            }
        return false;
    }
};
}

__device__ __forceinline__ void transpose_item(const float* W, int N, bf16_t* WT, int dst_ld, int dst_row0, int dst_k0, int k0, int n0, LAS float* scr, int lane) {
#pragma unroll 8
    for (int i = 0; i < 32; ++i) { const int kk = 2 * i + (lane >> 5); scr[kk * 33 + (lane & 31)] = W[(size_t)(k0 + kk) * N + n0 + (lane & 31)]; }
    asm volatile("s_waitcnt lgkmcnt(0)" ::: "memory");
    const int c = lane & 7;
#pragma unroll
    for (int j = 0; j < 4; ++j) { const int n = (lane >> 3) + 8 * j; const LAS float* s = scr + (8 * c) * 33 + n;
        u32x4 o; o.x = pk2(s[0 * 33], s[1 * 33]); o.y = pk2(s[2 * 33], s[3 * 33]); o.z = pk2(s[4 * 33], s[5 * 33]); o.w = pk2(s[6 * 33], s[7 * 33]);
        *(u32x4*)(WT + (size_t)(dst_row0 + n) * dst_ld + dst_k0 + 8 * c) = o; }
    asm volatile("s_waitcnt lgkmcnt(0)" ::: "memory");
}
__device__ __forceinline__ void rms_row_to_bf16(const float* xrow, const float* gain, bf16_t* orow, int lane) {
    const f32x4* xr = (const f32x4*)xrow + lane; const f32x4* gr = (const f32x4*)gain + lane;
    f32x4 v[8]; float s = 0.f;
#pragma unroll
    for (int j = 0; j < 8; ++j) { v[j] = xr[64 * j]; s += (v[j][0] * v[j][0] + v[j][1] * v[j][1]) + (v[j][2] * v[j][2] + v[j][3] * v[j][3]); }
    const float rstd = rsqrtf(wave_sum(s) * (1.0f / DM) + RMS_EPS);
    u32x2* o8 = (u32x2*)orow + lane;
#pragma unroll
    for (int j = 0; j < 8; ++j) { const f32x4 g = gr[64 * j]; u32x2 w; w.x = pk2(v[j][0] * rstd * g[0], v[j][1] * rstd * g[1]); w.y = pk2(v[j][2] * rstd * g[2], v[j][3] * rstd * g[3]); o8[64 * j] = w; }
}
template <bool XIB, bool XOB> __device__ __forceinline__ void rowpass(const bf16_t* Y, const float* part, const void* Xin, void* Xout, const float* g_post, const float* g_pre, bf16_t* Hout, int gw, int ngw, int lane_) {
    int lane = lane_; asm volatile("" : "+v"(lane));
    f32x4 gp[8];
#pragma unroll
    for (int j = 0; j < 8; ++j) gp[j] = ((const f32x4*)g_post)[lane + 64 * j];
    u32x2 ny[8]; f32x4 nxf[8]; u32x2 nxb[8]; float np = 0.f;
#define RP_LOAD(r) do { np = part[(size_t)(r) * 32 + (lane & 31)]; \
        const u32x2* yb_ = (const u32x2*)(Y + (size_t)(r) * DM) + lane; \
        _Pragma("unroll") for (int j = 0; j < 8; ++j) { ny[j] = yb_[64 * j]; \
            if (XIB) nxb[j] = ((const u32x2*)((const bf16_t*)Xin + (size_t)(r) * DM) + lane)[64 * j]; else nxf[j] = ((const f32x4*)((const float*)Xin + (size_t)(r) * DM) + lane)[64 * j]; } } while (0)
    int row = gw;
    if (row < T) RP_LOAD(row);
    for (; row < T; row += ngw) {
        u32x2 cy[8]; f32x4 cx[8]; float p = np;
#pragma unroll
        for (int j = 0; j < 8; ++j) { cy[j] = ny[j]; if (XIB) cx[j] = (f32x4){bflo(nxb[j].x), bfhi(nxb[j].x), bflo(nxb[j].y), bfhi(nxb[j].y)}; else cx[j] = nxf[j]; }
        if (row + ngw < T) RP_LOAD(row + ngw);
#pragma unroll
        for (int o = 1; o < 32; o <<= 1) p += __shfl_xor(p, o);
        const float rstd = rsqrtf(p * (1.0f / DM) + RMS_EPS);
        f32x4* of = (f32x4*)((float*)Xout + (size_t)row * DM) + lane; u32x2* ob = (u32x2*)((bf16_t*)Xout + (size_t)row * DM) + lane;
        f32x4 v[8]; float s = 0.f;
#pragma unroll
        for (int j = 0; j < 8; ++j) {
            const f32x4 y = {bflo(cy[j].x), bfhi(cy[j].x), bflo(cy[j].y), bfhi(cy[j].y)};
            v[j] = cx[j] + y * rstd * gp[j];
            if (XOB) { u32x2 o2; o2.x = pk2(v[j][0], v[j][1]); o2.y = pk2(v[j][2], v[j][3]); ob[64 * j] = o2; } else of[64 * j] = v[j];
            s += (v[j][0] * v[j][0] + v[j][1] * v[j][1]) + (v[j][2] * v[j][2] + v[j][3] * v[j][3]);
        }
        if (Hout) {
            const float r2 = rsqrtf(wave_sum(s) * (1.0f / DM) + RMS_EPS);
            const f32x4* gq = (const f32x4*)g_pre + lane; u32x2* o8 = (u32x2*)(Hout + (size_t)row * DM) + lane;
#pragma unroll
            for (int j = 0; j < 8; ++j) { const f32x4 g = gq[64 * j]; u32x2 w; w.x = pk2(v[j][0] * r2 * g[0], v[j][1] * r2 * g[1]); w.y = pk2(v[j][2] * r2 * g[2], v[j][3] * r2 * g[3]); o8[64 * j] = w; }
        }
    }
#undef RP_LOAD
}

#define LDS_BAR do { asm volatile("s_waitcnt lgkmcnt(0)" ::: "memory"); __builtin_amdgcn_s_barrier(); asm volatile("" ::: "memory"); } while (0)
__device__ __forceinline__ void attn_units(LAS unsigned char* lds, const bf16_t* Q, const bf16_t* Kk, const bf16_t* VT, const float* sinks, bf16_t* Y, int bid, int G, int tid) {
    const int lane = tid & 63, wave = tid >> 6, g = lane >> 4, n = lane & 15;
    LAS bf16_t* KL = (LAS bf16_t*)lds;
    LAS bf16_t* VL = (LAS bf16_t*)(lds + 36864);
    for (int it = bid; it < 512; it += G) {
        const int kvh = it & 3, blk = (it >> 2) & 63, b = it >> 8, s0 = blk * 128 + wave * 16, ks = blk * 128 - 128; const size_t tokb = (size_t)b * SEQ;
        u32x4 kst[4], vst[4];
#pragma unroll
        for (int ps = 0; ps < 4; ++ps) { const int row = ps * 64 + (tid >> 3), kr = ks + row; kst[ps] = *(const u32x4*)(Kk + (tokb + (kr < 0 ? 0 : kr)) * 256 + kvh * 64 + 8 * (tid & 7)); }
#pragma unroll
        for (int ps = 0; ps < 4; ++ps) { const int row = ps * 16 + (tid >> 5), kc = ks + 8 * (tid & 31); vst[ps] = *(const u32x4*)(VT + (size_t)(kvh * 64 + row) * T + tokb + (kc < 0 ? 0 : kc)); }
        const bf16_t* qp = Q + (tokb + s0 + n) * 1024 + (kvh * 4) * 64 + 8 * g;
        bf16x8 qf[2];
        qf[0] = *(const bf16x8*)qp; qf[1] = *(const bf16x8*)(qp + 32);
#pragma unroll
        for (int ps = 0; ps < 4; ++ps) *(LAS u32x4*)(KL + (ps * 64 + (tid >> 3)) * 72 + 8 * (tid & 7)) = kst[ps];
#pragma unroll
        for (int ps = 0; ps < 4; ++ps) *(LAS u32x4*)(VL + (ps * 16 + (tid >> 5)) * 264 + 8 * (tid & 31)) = vst[ps];
        __syncthreads();
        bf16x8 kf[9][2];
#pragma unroll
        for (int j = 0; j < 9; ++j) { const LAS bf16_t* kp = KL + (16 * wave + 16 * j + n) * 72 + 8 * g; kf[j][0] = *(const LAS bf16x8*)kp; kf[j][1] = *(const LAS bf16x8*)(kp + 32); }
        bf16x8 pf[4][5]; float inv[4];
#pragma unroll
        for (int hh = 0; hh < 4; ++hh) {
            f32x4 sc[9];
#pragma unroll
            for (int j = 0; j < 9; ++j) { f32x4 a = {0.f, 0.f, 0.f, 0.f}; a = mfma16(kf[j][0], qf[0], a); a = mfma16(kf[j][1], qf[1], a); sc[j] = a; }
            if (hh < 3) { qf[0] = *(const bf16x8*)(qp + (hh + 1) * 64); qf[1] = *(const bf16x8*)(qp + (hh + 1) * 64 + 32); }
            const float sink = sinks[kvh * 4 + hh];
            float mx = sink;
#pragma unroll
            for (int j = 0; j < 9; ++j) {
                const int key0 = s0 - 128 + 16 * j;
#pragma unroll
                for (int i = 0; i < 4; ++i) {
                    const int kr = 4 * g + i;
                    bool valid = key0 >= 0;
                    if (j == 0) valid = valid && (kr >= n + 1);
                    if (j == 8) valid = valid && (kr <= n);
                    const float v = valid ? sc[j][i] : -1e30f;
                    sc[j][i] = v; mx = fmaxf(mx, v);
                }
            }
            mx = fmaxf(mx, __shfl_xor(mx, 16)); mx = fmaxf(mx, __shfl_xor(mx, 32));
            float l = 0.f;
#pragma unroll
            for (int j = 0; j < 9; ++j)
#pragma unroll
                for (int i = 0; i < 4; ++i) { const float p = __expf(sc[j][i] - mx); sc[j][i] = p; l += p; }
            l += __shfl_xor(l, 16); l += __shfl_xor(l, 32);
            l += __expf(sink - mx);
            inv[hh] = 1.0f / l;
#pragma unroll
            for (int ks5 = 0; ks5 < 5; ++ks5) {
                const f32x4 pa = sc[2 * ks5]; const f32x4 pb = (2 * ks5 + 1 < 9) ? sc[(2 * ks5 + 1 < 9) ? 2 * ks5 + 1 : 0] : (f32x4){0.f, 0.f, 0.f, 0.f};
                u32x4 w; w.x = pk2_sw(pa[0], pa[1]); w.y = pk2_sw(pa[2], pa[3]); w.z = pk2_sw(pb[0], pb[1]); w.w = pk2_sw(pb[2], pb[3]);
                pf[hh][ks5] = __builtin_bit_cast(bf16x8, w);
            }
        }
#pragma unroll
        for (int dt = 0; dt < 4; ++dt) {
            const LAS bf16_t* vrow = VL + (dt * 16 + n) * 264 + 16 * wave + 4 * g;
            bf16x8 vf[5];
#pragma unroll
            for (int ks5 = 0; ks5 < 5; ++ks5) {
                const u32x2 va = *(const LAS u32x2*)(vrow + 32 * ks5);
                u32x2 vb = {0u, 0u}; if (ks5 < 4) vb = *(const LAS u32x2*)(vrow + 32 * ks5 + 16);
                u32x4 w; w.x = va.x; w.y = va.y; w.z = vb.x; w.w = vb.y; vf[ks5] = __builtin_bit_cast(bf16x8, w);
            }
#pragma unroll
            for (int hh = 0; hh < 4; ++hh) {
                f32x4 acc = {0.f, 0.f, 0.f, 0.f};
#pragma unroll
                for (int ks5 = 0; ks5 < 5; ++ks5) acc = mfma16(vf[ks5], pf[hh][ks5], acc);
                u32x2 o; o.x = pk2_sw(acc[0] * inv[hh], acc[1] * inv[hh]); o.y = pk2_sw(acc[2] * inv[hh], acc[3] * inv[hh]);
                *(u32x2*)(Y + (tokb + s0 + n) * DM + (kvh * 4 + hh) * 64 + dt * 16 + 4 * g) = o;
            }
        }
        __syncthreads();
    }
}

__device__ __forceinline__ void hgrn_passA_units(LAS unsigned char* lds, const bf16_t* HZ, const bf16_t* HVT, const float* LB, bf16_t* U, float* DC, int bid, int G, int tid) {
    const int k = tid & 127, I = tid >> 7, lane = tid & 63, w = tid >> 6, g = lane >> 4, n = lane & 15;
    LAS float* TOT = (LAS float*)lds;
    LAS bf16_t* KT = (LAS bf16_t*)(lds + 2048);
    LAS bf16_t* VS = (LAS bf16_t*)(lds + 2048 + 18432);
#define PA_DECODE(r_) const int h = (r_) & 7, c = ((r_) >> 3) & 127, b = (r_) >> 10; const size_t tok0 = (size_t)b * SEQ + (size_t)c * 64; const int ch = (b * 8 + h) * 128 + c;
#define PA_LOADZ(r_) do { PA_DECODE(r_) (void)ch; _Pragma("unroll") for (int i = 0; i < 16; ++i) zn[i] = HZ[(tok0 + 16 * I + i) * 1024 + h * 128 + k]; } while (0)
    unsigned short zn[16];
    int r = bid;
    if (r >= 2048) return;
    PA_LOADZ(r);
    for (; r < 2048; r += G) {
        PA_DECODE(r)
        const float lb = LB[h * 128 + k], oml = 1.0f - lb;
        unsigned short zc[16];
#pragma unroll
        for (int i = 0; i < 16; ++i) zc[i] = zn[i];
        u32x4 vst[2];
#pragma unroll
        for (int ps = 0; ps < 2; ++ps) vst[ps] = *(const u32x4*)(HVT + (size_t)(h * 128 + 64 * ps + (tid >> 3)) * T + tok0 + 8 * (tid & 7));
        if (r + G < 2048) PA_LOADZ(r + G);
        float cs[16], kk[16]; float run = 0.f;
#pragma unroll
        for (int i = 0; i < 16; ++i) {
            const float z = bf2f(zc[i]);
            const float e = __expf(-z), s = __builtin_amdgcn_rcpf(1.0f + e);
            run += __logf(lb + oml * s); cs[i] = run; kk[i] = oml * e * s;
        }
        TOT[I * 128 + k] = run;
        LDS_BAR;
        const float t0 = TOT[k], t1 = TOT[128 + k], t2 = TOT[256 + k], t3 = TOT[384 + k];
        const float rI = (I > 0 ? t0 : 0.f) + (I > 1 ? t1 : 0.f) + (I > 2 ? t2 : 0.f);
        const float blast = (t0 + t1) + (t2 + t3);
        unsigned pw[8];
#pragma unroll
        for (int i = 0; i < 8; ++i) pw[i] = pk2(kk[2 * i] * __expf(blast - rI - cs[2 * i]), kk[2 * i + 1] * __expf(blast - rI - cs[2 * i + 1]));
        LAS u32x4* kd = (LAS u32x4*)(KT + k * 72 + 16 * I);
        kd[0] = (u32x4){pw[0], pw[1], pw[2], pw[3]}; kd[1] = (u32x4){pw[4], pw[5], pw[6], pw[7]};
        if (I == 0) DC[(size_t)ch * 128 + k] = __expf(blast);
#pragma unroll
        for (int ps = 0; ps < 2; ++ps) *(LAS u32x4*)(VS + (64 * ps + (tid >> 3)) * 72 + 8 * (tid & 7)) = vst[ps];
        LDS_BAR;
        f32x4 acc[8];
#pragma unroll
        for (int d = 0; d < 8; ++d) acc[d] = (f32x4){0.f, 0.f, 0.f, 0.f};
#pragma unroll
        for (int st = 0; st < 2; ++st) {
            const bf16x8 a = *(const LAS bf16x8*)(KT + (16 * w + n) * 72 + 32 * st + 8 * g);
#pragma unroll
            for (int d = 0; d < 8; ++d) acc[d] = mfma16(a, *(const LAS bf16x8*)(VS + (16 * d + n) * 72 + 32 * st + 8 * g), acc[d]);
        }
#pragma unroll
        for (int d = 0; d < 8; ++d) { u32x2 o; o.x = pk2(acc[d][0], acc[d][1]); o.y = pk2(acc[d][2], acc[d][3]); *(u32x2*)(U + (size_t)ch * 16384 + (size_t)(16 * d + n) * 128 + 16 * w + 4 * g) = o; }
        LDS_BAR;
    }
#undef PA_DECODE
#undef PA_LOADZ
}

__device__ __forceinline__ void hgrn_passC(LAS unsigned char* lds, const bf16_t* HQ, const bf16_t* HZ, const bf16_t* HVT, const bf16_t* HG, const float* LB, const bf16_t* ST,
                                           const float* gnorm, bf16_t* Y, int b, int c, int h, int tid) {
    const int kp = tid & 63, sb = tid >> 6, I = sb >> 1, hf = sb & 1, lane = tid & 63, w = tid >> 6, g = lane >> 4, n = lane & 15;
    const size_t tok0 = (size_t)b * SEQ + (size_t)c * 64; const int ch = (b * 8 + h) * 128 + c;
    LAS float* TOT = (LAS float*)lds;
    LAS float* SS = (LAS float*)(lds + 4096);
    LAS bf16_t* QE = (LAS bf16_t*)(lds + 4608);
    LAS bf16_t* QI = QE + 64 * 136;
    LAS bf16_t* KB = QI + 64 * 136;
    LAS bf16_t* STS = (LAS bf16_t*)(lds + 82944);
    LAS bf16_t* VS = (LAS bf16_t*)(lds + 117760);
    const f32x2 lb2 = *(const f32x2*)(LB + h * 128 + 2 * kp);
    const int Iw = w & 3, dvh = w >> 2;
    unsigned zr[8], qr[8];
#pragma unroll
    for (int i = 0; i < 8; ++i) { zr[i] = *(const unsigned*)(HZ + (tok0 + 8 * sb + i) * 1024 + h * 128 + 2 * kp); qr[i] = *(const unsigned*)(HQ + (tok0 + 8 * sb + i) * 1024 + h * 128 + 2 * kp); }
    u32x4 sts[4], vst[2]; u32x2 hgv[4];
#pragma unroll
    for (int ps = 0; ps < 4; ++ps) sts[ps] = *(const u32x4*)(ST + (size_t)ch * 16384 + (size_t)(32 * ps + (tid >> 4)) * 128 + 8 * (tid & 15));
#pragma unroll
    for (int ps = 0; ps < 2; ++ps) vst[ps] = *(const u32x4*)(HVT + (size_t)(h * 128 + 64 * ps + (tid >> 3)) * T + tok0 + 8 * (tid & 7));
#pragma unroll
    for (int d4 = 0; d4 < 4; ++d4) hgv[d4] = *(const u32x2*)(HG + (tok0 + 16 * Iw + n) * 1024 + h * 128 + 16 * (4 * dvh + d4) + 4 * g);
    float cs[2][8], kk[2][8]; float run[2] = {0.f, 0.f};
#pragma unroll
    for (int i = 0; i < 8; ++i)
#pragma unroll
        for (int cc = 0; cc < 2; ++cc) {
            const float z = cc ? bfhi(zr[i]) : bflo(zr[i]); const float lb = lb2[cc], oml = 1.0f - lb;
            const float e = __expf(-z), s_ = __builtin_amdgcn_rcpf(1.0f + e);
            run[cc] += __logf(lb + oml * s_); cs[cc][i] = run[cc]; kk[cc][i] = oml * e * s_;
        }
    *(LAS f32x2*)(TOT + sb * 128 + 2 * kp) = (f32x2){run[0], run[1]};
    __syncthreads();
    f32x2 tt[7];
#pragma unroll
    for (int j = 0; j < 7; ++j) tt[j] = *(const LAS f32x2*)(TOT + j * 128 + 2 * kp);
    float eI[2], fI[2][4], pre[2];
#pragma unroll
    for (int cc = 0; cc < 2; ++cc) {
        const float r1 = tt[0][cc] + tt[1][cc], r2 = r1 + tt[2][cc] + tt[3][cc], r3 = r2 + tt[4][cc] + tt[5][cc];
        const float rI = (I == 0) ? 0.f : (I == 1) ? r1 : (I == 2) ? r2 : r3;
        const float tfirst = (I == 0) ? tt[0][cc] : (I == 1) ? tt[2][cc] : (I == 2) ? tt[4][cc] : tt[6][cc];
        pre[cc] = hf ? tfirst : 0.f;
        eI[cc] = __expf(rI);
        fI[cc][0] = __expf(0.f - rI); fI[cc][1] = __expf(r1 - rI); fI[cc][2] = __expf(r2 - rI); fI[cc][3] = __expf(r3 - rI);
    }
#pragma unroll
    for (int i = 0; i < 8; ++i) {
        const int t = 8 * sb + i, rowb = 8 * hf + i;
        float qi[2], kinv[2];
#pragma unroll
        for (int cc = 0; cc < 2; ++cc) { const float ecs = __expf(pre[cc] + cs[cc][i]); qi[cc] = (cc ? bfhi(qr[i]) : bflo(qr[i])) * ecs; kinv[cc] = kk[cc][i] * __builtin_amdgcn_rcpf(ecs); }
        *(LAS unsigned*)(QE + t * 136 + 2 * kp) = cvtpk_(qi[0] * eI[0], qi[1] * eI[1]);
        *(LAS unsigned*)(QI + t * 136 + 2 * kp) = cvtpk_(qi[0], qi[1]);
#pragma unroll
        for (int Ip = 0; Ip < 4; ++Ip) {
            if (Ip >= I) {
                const int blk = Ip * (Ip + 1) / 2 + I;
                *(LAS unsigned*)(KB + (blk * 16 + rowb) * 136 + 2 * kp) = cvtpk_(kinv[0] * fI[0][Ip], kinv[1] * fI[1][Ip]);
            }
        }
    }
#pragma unroll
    for (int ps = 0; ps < 4; ++ps) *(LAS u32x4*)(STS + (32 * ps + (tid >> 4)) * 136 + 8 * (tid & 15)) = sts[ps];
#pragma unroll
    for (int ps = 0; ps < 2; ++ps) *(LAS u32x4*)(VS + (64 * ps + (tid >> 3)) * 72 + 8 * (tid & 7)) = vst[ps];
    __syncthreads();
    f32x4 at[4];
#pragma unroll
    for (int J = 0; J < 4; ++J) {
        f32x4 a4 = {0.f, 0.f, 0.f, 0.f};
        if (J <= Iw) {
            const int blk = Iw * (Iw + 1) / 2 + J;
#pragma unroll
            for (int st = 0; st < 4; ++st) {
                const bf16x8 a = *(const LAS bf16x8*)(KB + (blk * 16 + n) * 136 + 32 * st + 8 * g);
                const bf16x8 bq = *(const LAS bf16x8*)(QI + (16 * Iw + n) * 136 + 32 * st + 8 * g);
                a4 = mfma16(a, bq, a4);
            }
            if (J == Iw) {
#pragma unroll
                for (int i = 0; i < 4; ++i) if (4 * g + i > n) a4[i] = 0.f;
            }
        }
        at[J] = a4;
    }
    bf16x8 pf[2];
#pragma unroll
    for (int ks = 0; ks < 2; ++ks) { u32x4 wv; wv.x = pk2(at[2 * ks][0], at[2 * ks][1]); wv.y = pk2(at[2 * ks][2], at[2 * ks][3]); wv.z = pk2(at[2 * ks + 1][0], at[2 * ks + 1][1]); wv.w = pk2(at[2 * ks + 1][2], at[2 * ks + 1][3]);
        pf[ks] = __builtin_bit_cast(bf16x8, wv); }
    f32x4 o[4]; float ss = 0.f;
#pragma unroll
    for (int d4 = 0; d4 < 4; ++d4) {
        f32x4 acc = {0.f, 0.f, 0.f, 0.f};
#pragma unroll
        for (int st = 0; st < 4; ++st) {
            const bf16x8 bq = *(const LAS bf16x8*)(QE + (16 * Iw + n) * 136 + 32 * st + 8 * g);
            acc = mfma16(*(const LAS bf16x8*)(STS + (16 * (4 * dvh + d4) + n) * 136 + 32 * st + 8 * g), bq, acc);
        }
        const LAS bf16_t* vl = VS + (16 * (4 * dvh + d4) + n) * 72 + 4 * g;
        { const u32x2 v0 = *(const LAS u32x2*)vl, v1 = *(const LAS u32x2*)(vl + 16); u32x4 wv; wv.x = v0.x; wv.y = v0.y; wv.z = v1.x; wv.w = v1.y; acc = mfma16(__builtin_bit_cast(bf16x8, wv), pf[0], acc); }
        { const u32x2 v0 = *(const LAS u32x2*)(vl + 32), v1 = *(const LAS u32x2*)(vl + 48); u32x4 wv; wv.x = v0.x; wv.y = v0.y; wv.z = v1.x; wv.w = v1.y; acc = mfma16(__builtin_bit_cast(bf16x8, wv), pf[1], acc); }
        o[d4] = acc; ss += (acc[0] * acc[0] + acc[1] * acc[1]) + (acc[2] * acc[2] + acc[3] * acc[3]);
    }
    ss += __shfl_xor(ss, 16); ss += __shfl_xor(ss, 32);
    if (g == 0) SS[dvh * 64 + 16 * Iw + n] = ss;
    __syncthreads();
    const float tot = SS[16 * Iw + n] + SS[64 + 16 * Iw + n];
    const float rstd = rsqrtf(tot * (1.0f / 128.0f) + RMS_EPS);
#pragma unroll
    for (int d4 = 0; d4 < 4; ++d4) {
        const int dv = 16 * (4 * dvh + d4) + 4 * g;
        const f32x4 gn = *(const f32x4*)(gnorm + dv);
        const u32x2 hg = hgv[d4];
        u32x2 ov; ov.x = pk2(o[d4][0] * rstd * gn[0] * bflo(hg.x), o[d4][1] * rstd * gn[1] * bfhi(hg.x)); ov.y = pk2(o[d4][2] * rstd * gn[2] * bflo(hg.y), o[d4][3] * rstd * gn[3] * bfhi(hg.y));
        *(u32x2*)(Y + (tok0 + 16 * Iw + n) * DM + 1024 + h * 128 + dv) = ov;
    }
    __syncthreads();
}

#define XB_TMO      128
#define XB_XCNT(j)  (256  + 64 * (j))
#define XB_XSUB(j)  (1280 + 64 * (j))
#define XB_XGEN(j)  (2304 + 64 * (j))
#define XB_TOP      3328
#define XB_TOPGEN   3392
#define XCD_BAR_WORDS 3456
#define XB_SPIN_CAP (1u << 18)
__device__ __forceinline__ unsigned xb_ld(unsigned* p)              { return __hip_atomic_load(p, __ATOMIC_RELAXED, __HIP_MEMORY_SCOPE_AGENT); }
__device__ __forceinline__ unsigned xb_add(unsigned* p, unsigned v) { return __hip_atomic_fetch_add(p, v, __ATOMIC_RELAXED, __HIP_MEMORY_SCOPE_AGENT); }
__device__ __forceinline__ unsigned xb_xcc_id() { return (unsigned)__builtin_amdgcn_s_getreg((3 << 11) | 20) & 0xFu; }
#define XB_SPIN(cond, bar) do { unsigned _sp = 0; while (cond) { __builtin_amdgcn_s_sleep(1); \
    if ((++_sp & 255u) == 0u) { if (xb_ld(&(bar)[XB_TMO])) break; if (_sp > XB_SPIN_CAP) { atomicAdd(&(bar)[XB_TMO], 1u); break; } } } } while (0)
__device__ __forceinline__ void xcd_barrier_complete(unsigned* bar, unsigned x, unsigned& nloc, unsigned& nx) {
    const unsigned G = gridDim.x * gridDim.y * gridDim.z;
    unsigned sum, cnt, mine, sp = 0u;
    for (;;) {
        sum = 0u; cnt = 0u; mine = 0u;
#pragma unroll
        for (unsigned j = 0; j < 16; ++j) { const unsigned c = xb_ld(&bar[XB_XCNT(j)]); sum += c; cnt += (c > 0u) ? 1u : 0u; mine = (j == x) ? c : mine; }
        if (sum == G) break;
        __builtin_amdgcn_s_sleep(1);
        if ((++sp & 255u) == 0u) { if (xb_ld(&bar[XB_TMO])) break; if (sp > XB_SPIN_CAP) { atomicAdd(&bar[XB_TMO], 1u); break; } }
    }
    nloc = mine > 0u ? mine : 1u; nx = cnt > 0u ? cnt : 1u;
}
__device__ __forceinline__ void xcd_barrier(unsigned* bar, volatile LAS unsigned* st, bool tid0) {
    asm volatile("s_waitcnt vmcnt(0)" ::: "memory");
    __syncthreads();
    if (tid0) {
        const unsigned x = xb_xcc_id();
        __builtin_amdgcn_s_waitcnt(0);
        unsigned nloc = st[0], nx = st[1];
        if (nloc == 0u) { xcd_barrier_complete(bar, x, nloc, nx); st[0] = nloc; st[1] = nx; }
        const unsigned old = xb_add(&bar[XB_XSUB(x)], 1u);
        const unsigned gen = old / nloc;
        if (old + 1u == (gen + 1u) * nloc) {
            __builtin_amdgcn_fence(__ATOMIC_RELEASE, "agent");
            asm volatile("s_waitcnt vmcnt(0)" ::: "memory");
            const unsigned og = xb_add(&bar[XB_TOP], 1u);
            const unsigned tg = og / nx;
            if (og + 1u == (tg + 1u) * nx) xb_add(&bar[XB_TOPGEN], 1u);
            else XB_SPIN(xb_ld(&bar[XB_TOPGEN]) == tg, bar);
            __builtin_amdgcn_fence(__ATOMIC_ACQUIRE, "agent");
            xb_add(&bar[XB_XGEN(x)], 1u);
            asm volatile("s_waitcnt vmcnt(0)" ::: "memory");
        } else {
            XB_SPIN(xb_ld(&bar[XB_XGEN(x)]) == gen, bar);
            __builtin_amdgcn_fence(__ATOMIC_ACQUIRE, "agent");
            asm volatile("s_waitcnt vmcnt(0)" ::: "memory");
        }
    }
    __syncthreads();
}

__device__ __forceinline__ void counter_barrier(unsigned* cnt, unsigned target, bool tid0) {
    __builtin_amdgcn_fence(__ATOMIC_RELEASE, "agent");
    asm volatile("s_waitcnt vmcnt(0)" ::: "memory");
    __syncthreads();
    if (tid0) {
        __hip_atomic_fetch_add(cnt, 1u, __ATOMIC_RELAXED, __HIP_MEMORY_SCOPE_AGENT);
        while (__hip_atomic_load(cnt, __ATOMIC_RELAXED, __HIP_MEMORY_SCOPE_AGENT) < target) __builtin_amdgcn_s_sleep(2);
    }
    __syncthreads();
    __builtin_amdgcn_fence(__ATOMIC_ACQUIRE, "agent");
    asm volatile("s_waitcnt vmcnt(0)" ::: "memory");
}

#ifndef PHASE_MASK
#define PHASE_MASK 0xFFFFF
#endif
#ifndef REP_MASK
#define REP_MASK 0
#endif
#define PH(k) if constexpr ((PHASE_MASK >> (k)) & 1) _Pragma("nounroll") for (int rep_ = 0; rep_ < ((((REP_MASK) >> (k)) & 1) ? 2 : 1); ++rep_)
constexpr int IT_IN = 32 * 304, IT_GU = 32 * 352, IT_DN = 88 * 64, IT_SQ = 32 * 64, IT_BR = 16 * 64, IT_PP = 4 * 64;
constexpr int IT_REST = IT_DN + 2 * IT_SQ + 2 * IT_BR + IT_PP;
struct Args { const float* in[20]; float* out; unsigned char* ws; };
enum { I_X = 0, I_P, I_POS, I_GMIXPRE, I_WIN, I_SINKS, I_LBL, I_GNORM, I_WATT, I_WHGRN, I_WOUT, I_GMIXPOST, I_GFFNPRE, I_WGU, I_WDN, I_GFFNPOST, I_GPLEPRE, I_WPG, I_WPP, I_GPLEPOST };

__device__ __forceinline__ int my_lane_() { int l; asm volatile("v_mbcnt_lo_u32_b32 %0, -1, 0\n\tv_mbcnt_hi_u32_b32 %0, -1, %0" : "=v"(l)); return l; }
__device__ __forceinline__ void* ldptr(LAS unsigned long long* PT, int k) {
    const unsigned long long v = PT[k];
    const unsigned lo = __builtin_amdgcn_readfirstlane((unsigned)v), hi = __builtin_amdgcn_readfirstlane((unsigned)(v >> 32));
    return (void*)(__attribute__((address_space(1))) void*)(((unsigned long long)hi << 32) | lo);
}
__global__ void __launch_bounds__(512, 2) fwd_megakernel(Args a) {
    extern __shared__ __attribute__((aligned(16))) unsigned char lds_raw[];
    LAS unsigned char* lds = (LAS unsigned char*)lds_raw;
    cg::grid_group grid = cg::this_grid();
    const int G = gridDim.x, bid = blockIdx.x, ngw = G * 8;
    const int wave_s = __builtin_amdgcn_readfirstlane((int)threadIdx.x >> 6);
#define MYLANE my_lane_()
#define MYTID (wave_s * 64 + MYLANE)
#define PH_IDS int tid_l = MYTID; asm volatile("" : "+v"(tid_l)); const int tid = tid_l, lane = tid & 63, wave = __builtin_amdgcn_readfirstlane(tid >> 6), gw = bid * 8 + wave; (void)lane; (void)gw;
    LAS unsigned long long* PT = (LAS unsigned long long*)(lds + 146432 + 64);
    volatile LAS unsigned* XST = (volatile LAS unsigned*)(lds + 146432);
    if (threadIdx.x == 0) {
#pragma unroll
        for (int i = 0; i < 20; ++i) PT[i] = (unsigned long long)a.in[i];
        PT[20] = (unsigned long long)a.out; PT[21] = (unsigned long long)a.ws;
        XST[0] = 0u; XST[1] = 0u;
        (void)xb_add((unsigned*)a.ws + XB_XCNT(xb_xcc_id()), 1u);
    }
    __syncthreads();
#define GSYNC xcd_barrier((unsigned*)ws, XST, MYTID == 0)
#define LDP(k) ldptr(PT, (k))
#define INF(k) ((const float*)LDP(k))
#define OUTP ((float*)LDP(20))
    unsigned char* ws = (unsigned char*)LDP(21);
#define WIN ((bf16_t*)(ws + WS_WIN))
#define WMRG ((bf16_t*)(ws + WS_WMRG))
#define WOUT ((bf16_t*)(ws + WS_WOUT))
#define WGU ((bf16_t*)(ws + WS_WGU))
#define WDN ((bf16_t*)(ws + WS_WDN))
#define WPG ((bf16_t*)(ws + WS_WPG))
#define WPP ((bf16_t*)(ws + WS_WPP))
#define HB ((bf16_t*)(ws + WS_HB))
#define PB ((bf16_t*)(ws + WS_PB))
#define ROPE ((float*)(ws + WS_ROPE))
#define LB ((float*)(ws + WS_LB))
#define DC ((float*)(ws + WS_DC))
#define PART ((float*)(ws + WS_PART))
#define Qb ((bf16_t*)(ws + WS_Q))
#define Kb ((bf16_t*)(ws + WS_K))
#define VT ((bf16_t*)(ws + WS_VT))
#define HQ ((bf16_t*)(ws + WS_HQ))
#define HZ ((bf16_t*)(ws + WS_HZ))
#define HVT ((bf16_t*)(ws + WS_HVT))
#define HG ((bf16_t*)(ws + WS_HG))
#define GSA ((bf16_t*)(ws + WS_GSA))
#define GSB ((bf16_t*)(ws + WS_GSB))
#define STb ((bf16_t*)(ws + WS_ST))
#define MRG ((bf16_t*)(ws + WS_MRG))
#define ACT ((bf16_t*)(ws + WS_ACT))
#define Y1 ((bf16_t*)(ws + WS_Y1))
#define Y2 ((bf16_t*)(ws + WS_Y2))
#define E0 ((bf16_t*)(ws + WS_E0))
#define EB ((bf16_t*)(ws + WS_E))
#define U ((bf16_t*)OUTP)

    PH(0) { PH_IDS
        LAS float* scr = (LAS float*)(lds + wave * 16384);
        for (int it = gw; it < IT_IN + IT_GU; it += ngw) {
            int r = it;
            if (r < IT_IN) { const int kb = r / 304, nb = r % 304, n0 = 32 * nb; int dr = n0;
                if (n0 < 1280) { const int pn = n0 >> 8, c = n0 & 255, head = c >> 6, hf = (c & 63) >> 5; dr = pn * 256 + 128 * hf + head * 32; }
                else if (n0 >= 5632) { const int isb = n0 >= 7680, jj = isb ? n0 - 7680 : n0 - 5632; dr = 5632 + (jj >> 7) * 256 + 128 * isb + (jj & 127); }
                transpose_item(INF(I_WIN), INW, WIN, 2048, dr, 64 * kb, 64 * kb, n0, scr, lane); continue; } r -= IT_IN;
            { const int kb = r / 352, nb = r % 352, n0 = 32 * nb; const int up = n0 >= DFF, j = up ? n0 - DFF : n0; const int dr = (j >> 7) * 256 + 128 * up + (j & 127);
                transpose_item(INF(I_WGU), NGU, WGU, 2048, dr, 64 * kb, 64 * kb, n0, scr, lane); }
        }
        for (int m = gw; m < T; m += ngw) rms_row_to_bf16(INF(I_X) + (size_t)m * DM, INF(I_GMIXPRE), HB + (size_t)m * DM, lane);
        const int gt = bid * 512 + tid, ngt = G * 512;
        const int* pos = (const int*)INF(I_POS);
        for (int i = gt; i < T * 32; i += ngt) { const int t = i >> 5, d = i & 31;
            const float invf = powf(10000.0f, -(float)d * (1.0f / 32.0f)); const float ang = (float)pos[t] * invf;
            const double rev = (double)ang * 0.15915494309189535; const float fr = (float)(rev - rint(rev));
            ROPE[(size_t)t * 64 + d] = __builtin_amdgcn_cosf(fr); ROPE[(size_t)t * 64 + 32 + d] = __builtin_amdgcn_sinf(fr); }
        for (int i = gt; i < 1024; i += ngt) { const float l0 = INF(I_LBL)[i], l1 = INF(I_LBL)[1024 + i]; LB[i] = 1.0f / (1.0f + expf(l1 - l0)); }
    }
    GSYNC;
    if (G > (1 << 20)) grid.sync();

    PH(1) {
        pg8::Gemm g{HB, WIN, 2048, 32}; pg8::StaticOrder S; S.init(T, INW, G, bid);
        pg8::EpiProj E{ws};
        pg8::gemm_phase(lds, g, S, E, MYTID);
        const int rem = ((T / 256) * (INW / 256)) % G;
        if (rem == 0 || bid >= rem) { PH_IDS (void)gw;
            LAS float* scr = (LAS float*)(lds + wave * 16384);
            const int first = (rem == 0 ? bid : bid - rem) * 8 + wave, step = (rem == 0 ? G : G - rem) * 8;
            {
                const int gt2 = (rem == 0 ? bid : bid - rem) * 512 + tid, ngt2 = (rem == 0 ? G : G - rem) * 512;
                for (int i = gt2; i < T * 64; i += ngt2) { const f32x4 v = ((const f32x4*)INF(I_P))[i]; u32x2 w; w.x = pk2(v[0], v[1]); w.y = pk2(v[2], v[3]); ((u32x2*)PB)[i] = w; }
            }
            for (int it = first; it < IT_REST; it += step) {
                int r = it;
                if (r < IT_DN) { const int kb = r / 64, nb = r % 64; transpose_item(INF(I_WDN), DM, WDN, DFF, 32 * nb, 64 * kb, 64 * kb, 32 * nb, scr, lane); continue; } r -= IT_DN;
                if (r < IT_SQ) { const int kb = r / 64, nb = r % 64; transpose_item(INF(I_WOUT), DM, WOUT, 2048, 32 * nb, 64 * kb, 64 * kb, 32 * nb, scr, lane); continue; } r -= IT_SQ;
                if (r < IT_SQ) { const int kb = r / 64, nb = r % 64; transpose_item(INF(I_WPG), DM, WPG, 2048, 32 * nb, 64 * kb, 64 * kb, 32 * nb, scr, lane); continue; } r -= IT_SQ;
                if (r < IT_BR) { const int kb = r / 64, nb = r % 64; transpose_item(INF(I_WATT), DM, WMRG, 2048, 32 * nb, 64 * kb, 64 * kb, 32 * nb, scr, lane); continue; } r -= IT_BR;
                if (r < IT_BR) { const int kb = r / 64, nb = r % 64; transpose_item(INF(I_WHGRN), DM, WMRG, 2048, 32 * nb, 1024 + 64 * kb, 64 * kb, 32 * nb, scr, lane); continue; } r -= IT_BR;
                { const int kb = r / 64, nb = r % 64; transpose_item(INF(I_WPP), DM, WPP, 256, 32 * nb, 64 * kb, 64 * kb, 32 * nb, scr, lane); }
            }
        }
    }
    GSYNC;

    PH(2) {
        { PH_IDS (void)wave; attn_units(lds, Qb, Kb, VT, INF(I_SINKS), HB, bid, G, tid); }
        { PH_IDS (void)wave; hgrn_passA_units(lds, HZ, HVT, LB, U, DC, bid, G, tid); }
    }
    GSYNC;

    PH(3) { PH_IDS
        const int gt = bid * 512 + tid, ngt = G * 512;
        for (int item = gt; item < 16 * 128 * 64; item += ngt) {
            const int kp = item & 63, dv = (item >> 6) & 127, bh = item >> 13;
            f32x2 s = {0.f, 0.f};
            const unsigned* up = (const unsigned*)(U + (size_t)bh * 128 * 16384 + (size_t)dv * 128) + kp;
            const f32x2* dp = (const f32x2*)(DC + (size_t)bh * 128 * 128) + kp;
            unsigned* sp = (unsigned*)(STb + (size_t)bh * 128 * 16384 + (size_t)dv * 128) + kp;
#pragma unroll 8
            for (int c = 0; c < 128; ++c) {
                sp[(size_t)c * 8192] = pk2(s[0], s[1]);
                const unsigned ub = up[(size_t)c * 8192]; const f32x2 u = {bflo(ub), bfhi(ub)}, d = dp[(size_t)c * 64];
                s = d * s + u;
            }
        }
    }
    GSYNC;

    PH(4) { PH_IDS
        bf16_t* YC = HB;
        for (int it = bid; it < 2048; it += G) { const int h = it & 7, c = (it >> 3) & 127, b = it >> 10;
            hgrn_passC(lds, HQ, HZ, HVT, HG, LB, STb, INF(I_GNORM), YC, b, c, h, tid); }
    }
    GSYNC;

    PH(5) {
        pg8::Gemm g{HB, WMRG, 2048, 16}; pg8::SplitKOrder S; S.b.init(T, DM, G, bid); S.kbytes = 1024 * 2;
        pg8::EpiMerged E{GSA, GSB, MRG};
        pg8::gemm_phase(lds, g, S, E, MYTID);
    }
    GSYNC;

    PH(6) {
        pg8::Gemm g{MRG, WOUT, 2048, 32}; pg8::StaticOrder S; S.init(T, DM, G, bid);
        pg8::EpiRowSSb E{Y1, PART};
        pg8::gemm_phase(lds, g, S, E, MYTID);
    }
    GSYNC;

    PH(7) { PH_IDS rowpass<false, true>(Y1, PART, INF(I_X), OUTP, INF(I_GMIXPOST), INF(I_GFFNPRE), HB, gw, ngw, lane); }
    GSYNC;

    PH(8) {
        pg8::Gemm g{HB, WGU, 2048, 32}; pg8::StaticOrder S; S.init(T, NGU, G, bid);
        pg8::EpiSwiglu E{ACT};
        pg8::gemm_phase(lds, g, S, E, MYTID);
    }
    GSYNC;

    PH(9) {
        pg8::Gemm g{ACT, WDN, DFF, DFF / 64}; pg8::StaticOrder S; S.init(T, DM, G, bid);
        pg8::EpiRowSSb E{Y2, PART};
        pg8::gemm_phase(lds, g, S, E, MYTID);
    }
    GSYNC;

    PH(10) { PH_IDS rowpass<true, true>(Y2, PART, OUTP, (void*)(ws + WS_X2), INF(I_GFFNPOST), INF(I_GPLEPRE), HB, gw, ngw, lane); }
    GSYNC;

    PH(11) {
        pg8::Gemm g{PB, WPP, 256, 4}; pg8::StaticOrder S; S.init(T, DM, G, bid);
        pg8::EpiE0 E{E0};
        pg8::gemm_phase(lds, g, S, E, MYTID);
    }
    __builtin_amdgcn_sched_barrier(0);
    PH(12) {
        pg8::Gemm g{HB, WPG, 2048, 32}; pg8::StaticOrder S; S.init(T, DM, G, bid);
        pg8::EpiPle E{E0, EB, PART};
        pg8::gemm_phase(lds, g, S, E, MYTID);
    }
    GSYNC;

    PH(13) { PH_IDS rowpass<true, false>(EB, PART, (const void*)(ws + WS_X2), OUTP, INF(I_GPLEPOST), nullptr, nullptr, gw, ngw, lane); }
}

extern "C" void kernel_launch(void* const* d_in, const int* in_sizes, int n_in, void* d_out, int out_size, void* d_ws, size_t ws_size, hipStream_t stream) {
    static int grid = 0;
    if (grid == 0) {
        if (n_in != 20 || out_size != T * DM || ws_size < WS_END) { fprintf(stderr, "kernel_launch: unexpected shapes (n_in %d out %d ws %zu)\n", n_in, out_size, ws_size); grid = -1; return; }
        int dev = 0, cus = 0, per_cu = 0;
        hipGetDevice(&dev); hipDeviceGetAttribute(&cus, hipDeviceAttributeMultiprocessorCount, dev);
        if (hipFuncSetAttribute((const void*)fwd_megakernel, hipFuncAttributeMaxDynamicSharedMemorySize, LDS_BYTES) != hipSuccess) { fprintf(stderr, "kernel_launch: hipFuncSetAttribute failed\n"); grid = -1; return; }
        if (hipOccupancyMaxActiveBlocksPerMultiprocessor(&per_cu, (const void*)fwd_megakernel, 512, LDS_BYTES) != hipSuccess || per_cu < 1) { fprintf(stderr, "kernel_launch: occupancy query gave %d\n", per_cu); per_cu = 1; }
        (void)hipGetLastError();
        grid = cus * 1;
        fprintf(stderr, "kernel_launch: grid %d (cus %d, per_cu %d)\n", grid, cus, per_cu);
    }
    if (grid < 0) return;
    if (hipMemsetAsync(d_ws, 0, 16384, stream) != hipSuccess) { fprintf(stderr, "kernel_launch: memset failed\n"); return; }
    Args a{};
    for (int i = 0; i < 20; ++i) a.in[i] = (const float*)d_in[i];
    a.out = (float*)d_out; a.ws = (unsigned char*)d_ws;
    void* args[] = {&a};
    hipError_t e = hipLaunchCooperativeKernel((const void*)fwd_megakernel, dim3(grid), dim3(512), args, LDS_BYTES, stream);
    if (e != hipSuccess) fprintf(stderr, "kernel_launch: cooperative launch failed: %s\n", hipGetErrorString(e));
}
```
